# Optimizing an MI355X kernel written in HIP

```python
import math
import jax, jax.numpy as jnp
from jax import lax
import numpy as np

D_MODEL = 1024
BATCH = 4
SEQ = 4096
DEPTH = 1

N_ATTN_HEADS = 8
HEAD_DIM = 64
ATTN_WIDTH = N_ATTN_HEADS * HEAD_DIM
N_RG_BLOCKS = 8
RG_WIDTH = 512
RG_BLOCK = RG_WIDTH // N_RG_BLOCKS
MIX_WIDTH = ATTN_WIDTH + RG_WIDTH
IN_COLS = 3 * ATTN_WIDTH + 2 * RG_WIDTH
DILATED_PATTERNS = ((128, 1), (512, 4), (2048, 16))
BAND_BLOCK = 64
ROPE_THETA = 10000.0
CONV_WIDTH = 4
CONV_PAD_LEFT = 2
CONV_PAD_RIGHT = 1
RG_C = 8.0
N_MEM = 256
N_CROSS_HEADS = 4
CROSS_HEAD_DIM = 128
CROSS_WIDTH = N_CROSS_HEADS * CROSS_HEAD_DIM
D_FF = 4 * D_MODEL
NORM_EPS = 1e-6
NEG_BIG = -1e30

kernel_name = "hybrid_dilated_attn_rglru_encoder_block"


def rmsnorm(x, g):
    xf = x.astype(jnp.float32)
    return xf * lax.rsqrt(jnp.mean(xf * xf, axis=-1, keepdims=True) + NORM_EPS) * g.astype(jnp.float32)


def rope(t, positions):
    half = t.shape[-1] // 2
    inv_freq = ROPE_THETA ** (-jnp.arange(half, dtype=jnp.float32) / half)
    ang = positions.astype(jnp.float32)[..., None] * inv_freq
    cos = jnp.cos(ang)[:, :, None, :]
    sin = jnp.sin(ang)[:, :, None, :]
    t1, t2 = t[..., :half], t[..., half:]
    return jnp.concatenate([t1 * cos - t2 * sin, t1 * sin + t2 * cos], axis=-1)


def banded_window_attention(q, k, v, radius):
    L, dh = q.shape[-2], q.shape[-1]
    blk = BAND_BLOCK
    nb = -(-L // blk)
    Lp = nb * blk
    lead = q.shape[:-2]
    nlead = len(lead)
    qb = jnp.pad(q, [(0, 0)] * nlead + [(0, Lp - L), (0, 0)]).reshape(*lead, nb, blk, dh)
    pad_both = [(0, 0)] * nlead + [(blk, Lp - L + blk), (0, 0)]
    kb = jnp.pad(k, pad_both).reshape(*lead, nb + 2, blk, dh)
    vb = jnp.pad(v, pad_both).reshape(*lead, nb + 2, blk, dh)
    kn = jnp.concatenate([kb[..., :-2, :, :], kb[..., 1:-1, :, :], kb[..., 2:, :, :]], axis=-2)
    vn = jnp.concatenate([vb[..., :-2, :, :], vb[..., 1:-1, :, :], vb[..., 2:, :, :]], axis=-2)
    s = jnp.einsum('...nqd,...nkd->...nqk', qb, kn) * (dh ** -0.5)
    qpos = jnp.arange(nb)[:, None] * blk + jnp.arange(blk)[None, :]
    kpos = (jnp.arange(nb)[:, None] - 1) * blk + jnp.arange(3 * blk)[None, :]
    dist = qpos[:, :, None] - kpos[:, None, :]
    valid = (jnp.abs(dist) <= radius) & (kpos[:, None, :] >= 0) & (kpos[:, None, :] < L)
    s = jnp.where(valid, s, NEG_BIG)
    m = jnp.max(s, axis=-1, keepdims=True)
    p = jnp.exp(s - m)
    denom = jnp.sum(p, axis=-1, keepdims=True)
    o = jnp.einsum('...nqk,...nkd->...nqd', p, vn) / denom
    lse = (m + jnp.log(denom))[..., 0]
    o = o.reshape(*lead, Lp, dh)[..., :L, :]
    lse = lse.reshape(*lead, Lp)[..., :L]
    return o, lse


def dilated_mixture_attention(q, k, v):
    B, S, H, dh = q.shape
    outs, lses = [], []
    for window, dil in DILATED_PATTERNS:
        L = S // dil

        def to_classes(t):
            return t.reshape(B, L, dil, H, dh).transpose(0, 2, 3, 1, 4)

        o, lse = banded_window_attention(to_classes(q), to_classes(k), to_classes(v), window // (2 * dil))
        outs.append(o.transpose(0, 3, 1, 2, 4).reshape(B, S, H, dh))
        lses.append(lse.transpose(0, 3, 1, 2).reshape(B, S, H))
    w = jax.nn.softmax(jnp.stack(lses, axis=0), axis=0)
    return jnp.sum(w[..., None] * jnp.stack(outs, axis=0), axis=0)


def centred_depthwise_conv(u, w, b):
    out = lax.conv_general_dilated(
        u, w[:, None, :].astype(u.dtype), window_strides=(1,),
        padding=[(CONV_PAD_LEFT, CONV_PAD_RIGHT)],
        dimension_numbers=('NWC', 'WIO', 'NWC'),
        feature_group_count=u.shape[-1])
    return out + b


def _linear_recurrence_combine(c1, c2):
    a1, b1 = c1
    a2, b2 = c2
    return a1 * a2, a2 * b1 + b2


def bidirectional_rglru(u, a_w, a_b, x_w, x_b, lam):
    B, S, _ = u.shape
    ug = u.reshape(B, S, N_RG_BLOCKS, RG_BLOCK)
    r = jax.nn.sigmoid(jnp.einsum('bsgi,zgij->zbsgj', ug, a_w) + a_b[:, None, None]).reshape(2, B, S, RG_WIDTH)
    i = jax.nn.sigmoid(jnp.einsum('bsgi,zgij->zbsgj', ug, x_w) + x_b[:, None, None]).reshape(2, B, S, RG_WIDTH)
    log_a = -RG_C * r * jax.nn.softplus(-lam.astype(jnp.float32))[:, None, None, :]
    a = jnp.exp(log_a)
    b = jnp.sqrt(-jnp.expm1(2.0 * log_a)) * (i * u[None])
    _, h_f = lax.associative_scan(_linear_recurrence_combine, (a[0], b[0]), axis=1)
    _, h_b = lax.associative_scan(_linear_recurrence_combine, (a[1], b[1]), axis=1, reverse=True)
    return h_f + h_b


def memory_cross_attention(xn, memn, wq, wk, wv, wo):
    B, S, _ = xn.shape
    M = memn.shape[1]
    q = (xn @ wq).reshape(B, S, N_CROSS_HEADS, CROSS_HEAD_DIM)
    k = (memn @ wk).reshape(B, M, N_CROSS_HEADS, CROSS_HEAD_DIM)
    v = (memn @ wv).reshape(B, M, N_CROSS_HEADS, CROSS_HEAD_DIM)
    s = jnp.einsum('bshd,bmhd->bhsm', q, k) * (CROSS_HEAD_DIM ** -0.5)
    p = jax.nn.softmax(s, axis=-1)
    o = jnp.einsum('bhsm,bmhd->bshd', p, v).reshape(B, S, CROSS_WIDTH)
    return o @ wo


def setup_inputs(seed: int = 0) -> dict:
    key = jax.random.key(seed)
    ks = jax.random.split(key, 24)
    f32 = jnp.float32

    def nrm(k, shape, scale):
        return jax.random.normal(k, shape, f32) * scale

    def gain(k, shape):
        return 1.0 + 0.05 * jax.random.normal(k, shape, f32)

    lam_u = jax.random.uniform(ks[11], (DEPTH, 2, RG_WIDTH), f32, minval=0.9, maxval=0.999)
    a0 = lam_u ** (1.0 / RG_C)
    rg_lambda = jnp.log(a0) - jnp.log1p(-a0)
    return {
        "x": nrm(ks[0], (BATCH, SEQ, D_MODEL), 1.0),
        "mem": nrm(ks[1], (BATCH, N_MEM, D_MODEL), 1.0),
        "positions": jnp.broadcast_to(jnp.arange(SEQ, dtype=jnp.int32), (BATCH, SEQ)),
        "norm_mix_g": gain(ks[2], (DEPTH, D_MODEL)),
        "w_in": nrm(ks[3], (DEPTH, D_MODEL, IN_COLS), D_MODEL ** -0.5),
        "conv_w": nrm(ks[4], (DEPTH, CONV_WIDTH, RG_WIDTH), CONV_WIDTH ** -0.5),
        "conv_b": nrm(ks[5], (DEPTH, RG_WIDTH), 0.01),
        "rg_a_w": nrm(ks[6], (DEPTH, 2, N_RG_BLOCKS, RG_BLOCK, RG_BLOCK), RG_BLOCK ** -0.5),
        "rg_a_b": nrm(ks[7], (DEPTH, 2, N_RG_BLOCKS, RG_BLOCK), 0.01),
        "rg_x_w": nrm(ks[8], (DEPTH, 2, N_RG_BLOCKS, RG_BLOCK, RG_BLOCK), RG_BLOCK ** -0.5),
        "rg_x_b": nrm(ks[9], (DEPTH, 2, N_RG_BLOCKS, RG_BLOCK), 0.01),
        "rg_lambda": rg_lambda,
        "w_out": nrm(ks[10], (DEPTH, MIX_WIDTH, D_MODEL), MIX_WIDTH ** -0.5),
        "norm_cross_g": gain(ks[12], (DEPTH, D_MODEL)),
        "norm_mem_g": gain(ks[13], (DEPTH, D_MODEL)),
        "w_cq": nrm(ks[14], (DEPTH, D_MODEL, CROSS_WIDTH), D_MODEL ** -0.5),
        "w_ck": nrm(ks[15], (DEPTH, D_MODEL, CROSS_WIDTH), D_MODEL ** -0.5),
        "w_cv": nrm(ks[16], (DEPTH, D_MODEL, CROSS_WIDTH), D_MODEL ** -0.5),
        "w_co": nrm(ks[17], (DEPTH, CROSS_WIDTH, D_MODEL), CROSS_WIDTH ** -0.5),
        "norm_mlp_g": gain(ks[18], (DEPTH, D_MODEL)),
        "w_mlp_in": nrm(ks[19], (DEPTH, D_MODEL, D_FF), D_MODEL ** -0.5),
        "w_mlp_out": nrm(ks[20], (DEPTH, D_FF, D_MODEL), D_FF ** -0.5),
        "norm_final_g": gain(ks[21], (D_MODEL,)),
    }


def reference(x, mem, positions, norm_mix_g, w_in, conv_w, conv_b, rg_a_w, rg_a_b, rg_x_w, rg_x_b,
              rg_lambda, w_out, norm_cross_g, norm_mem_g, w_cq, w_ck, w_cv, w_co,
              norm_mlp_g, w_mlp_in, w_mlp_out, norm_final_g):
    B, S, _ = x.shape
    h = x.astype(jnp.float32)
    memf = mem.astype(jnp.float32)
    for l in range(DEPTH):
        xn = rmsnorm(h, norm_mix_g[l])
        proj = xn @ w_in[l]
        q, k, v, u, y = jnp.split(proj, [ATTN_WIDTH, 2 * ATTN_WIDTH, 3 * ATTN_WIDTH,
                                         3 * ATTN_WIDTH + RG_WIDTH], axis=-1)
        q = rope(q.reshape(B, S, N_ATTN_HEADS, HEAD_DIM), positions)
        k = rope(k.reshape(B, S, N_ATTN_HEADS, HEAD_DIM), positions)
        v = v.reshape(B, S, N_ATTN_HEADS, HEAD_DIM)
        attn = dilated_mixture_attention(q, k, v).reshape(B, S, ATTN_WIDTH)
        uc = centred_depthwise_conv(u, conv_w[l], conv_b[l])
        rec = bidirectional_rglru(uc, rg_a_w[l], rg_a_b[l], rg_x_w[l], rg_x_b[l], rg_lambda[l]) * jax.nn.gelu(y)
        h = h + jnp.concatenate([attn, rec], axis=-1) @ w_out[l]
        h = h + memory_cross_attention(rmsnorm(h, norm_cross_g[l]), rmsnorm(memf, norm_mem_g[l]),
                                       w_cq[l], w_ck[l], w_cv[l], w_co[l])
        hid = jnp.square(jax.nn.relu(rmsnorm(h, norm_mlp_g[l]) @ w_mlp_in[l]))
        h = h + hid @ w_mlp_out[l]
    return rmsnorm(h, norm_final_g).astype(x.dtype)
```

```cpp
#include <hip/hip_runtime.h>
#include <cstdio>
#include <cstdint>
#include <cmath>

constexpr int NB = 4, SEQ = 4096, DM = 1024, NT = NB * SEQ, FF = 4096, NMEM = 256;
constexpr float NORM_EPS = 1e-6f;
constexpr float QSCALE = 0.125f * 1.4426950408889634f;
constexpr float CSCALE = 0.08838834764831845f * 1.4426950408889634f;

namespace pg8 {
#define PG8_LAS __attribute__((address_space(3)))
typedef unsigned short bf16_t;
typedef short bf16x8 __attribute__((ext_vector_type(8)));
typedef float f32x4 __attribute__((ext_vector_type(4)));
typedef float f32x2 __attribute__((ext_vector_type(2)));
typedef unsigned u32x4 __attribute__((ext_vector_type(4)));
typedef unsigned u32x2 __attribute__((ext_vector_type(2)));
constexpr int BM = 256, BK = 64, HALF = 128, HTB = HALF * BK * 2  , STAGE_BYTES = 8 * HTB, NXCD = 8, WGM = 8;

__host__ __device__ __forceinline__ int lds_byte(int r, int c) { const int st = (r >> 4) * 2 + (c >> 5), rr = r & 15, cc = c & 31, ob = rr * 64 + cc * 2; return st * 1024 + (ob ^ (((ob >> 9) & 1) << 5)); }
__host__ __device__ __forceinline__ void stage_rc(int b, int& R, int& C) { const int st = b / 1024, sb = b % 1024, swz = sb ^ (((sb >> 9) & 1) << 5); R = (st >> 1) * 16 + swz / 64; C = (st & 1) * 32 + (swz % 64) / 2; }
__host__ __device__ __forceinline__ int perm32(int rho) { const int n = rho >> 4, i = rho & 15; return 8 * (i >> 2) + 4 * n + (i & 3); }
__host__ __device__ __forceinline__ int perm_id(int R) { return R; }
__host__ __device__ __forceinline__ int perm_std(int R) { return (R & ~31) + perm32(R & 31); }
__host__ __device__ __forceinline__ int perm_rope(int R) { const int wc = R >> 5, rho = R & 31, n = rho >> 4, i = rho & 15; return 64 * (wc >> 1) + 32 * n + 16 * (wc & 1) + i; }

struct Unit { int pm, pn; };
struct Gemm { const bf16_t* A; const bf16_t* Bt; int K, lda, ldb, bshift; size_t bstride; };

struct StaticOrder {
    int nM, nN, nwg, G, c;
    __host__ __device__ void init(int M, int N, int G_, int c_) { nM = M / BM; nN = N / BM; nwg = nM * nN; G = G_; c = c_; }
    __host__ __device__ bool next(int i, Unit& u) const {
        const long L = (long)i * G + c; if (L >= nwg) return false;
        int wgid = (int)L; { const int q = nwg / NXCD, r = nwg % NXCD, xcd = wgid % NXCD, off = wgid / NXCD; wgid = (xcd < r ? xcd * (q + 1) : r * (q + 1) + (xcd - r) * q) + off; }
        const int nig = WGM * nN, gid = wgid / nig, fm = gid * WGM, gsz = (nM - fm) < WGM ? (nM - fm) : WGM;
        u.pm = fm + ((wgid % nig) % gsz); u.pn = (wgid % nig) / gsz; return true;
    }
    __device__ __forceinline__ void a_ready(const Unit&) const {}
    __device__ __forceinline__ void done(const Unit&) const {}
};
struct OrderP1 {
    StaticOrder base;
    __device__ bool next(int i, Unit& u) const {
        if (base.next(i, u)) return true;
        const long e = (long)i * base.G + base.c - base.nwg; if (e >= 16) return false;
        u.pm = 64 + (int)(e >> 2); u.pn = 10 + (int)(e & 3); return true;
    }
    __device__ __forceinline__ void a_ready(const Unit&) const {}
    __device__ __forceinline__ void done(const Unit&) const {}
};

__device__ __forceinline__ unsigned cvt_pk_bf16(float lo, float hi) { unsigned r; asm volatile("v_cvt_pk_bf16_f32 %0, %1, %2" : "=v"(r) : "v"(lo), "v"(hi)); return r; }
__device__ __forceinline__ float gelu_tanh_f(float x) {
    const float z2 = -2.0f * 1.4426950408889634f * 0.7978845608028654f * (x + 0.044715f * x * x * x);
    return x * __builtin_amdgcn_rcpf(1.0f + __builtin_amdgcn_exp2f(z2));
}
__device__ __forceinline__ float rstd_from_ssq16(const float* p) {
    const f32x4 a = *(const f32x4*)p, b = *(const f32x4*)(p + 4), c = *(const f32x4*)(p + 8), d = *(const f32x4*)(p + 12);
    const float s = ((a[0] + a[1]) + (a[2] + a[3])) + ((b[0] + b[1]) + (b[2] + b[3])) + ((c[0] + c[1]) + (c[2] + c[3])) + ((d[0] + d[1]) + (d[2] + d[3]));
    return 1.0f / sqrtf(s * (1.0f / 1024.0f) + NORM_EPS);
}


struct EpiProj {
    static constexpr bool AFTER_DRAIN = false;
    __host__ __device__ static __forceinline__ int perm_row(int R) { return perm_rope(R); }
    bf16_t *Q, *K, *V, *U, *G, *KVM; const float* rs0; const float* rsm; const float* tab;
    __device__ __forceinline__ void operator()(const f32x4 (&acc)[2][2][4][2], const Unit& u, int wr, int wc, int fr, int fq) const {
        const bool is_mem = u.pm >= 64;
        const int typ = is_mem ? 5 : (u.pn >> 1);
        const int colh = 64 * (wc >> 1) + 16 * (wc & 1) + 4 * fq;
        bf16_t* T; int pitch, col0; const float* rs; int rsub;
        if (is_mem) { T = KVM; pitch = 1024; col0 = (u.pn - 10) * 256 + colh; rs = rsm; rsub = 64 * 256; }
        else { T = typ == 0 ? Q : typ == 1 ? K : typ == 2 ? V : typ == 3 ? U : G; pitch = 512; col0 = (u.pn & 1) * 256 + colh; rs = rs0; rsub = 0; }
#pragma unroll
        for (int ai = 0; ai < 2; ++ai)
#pragma unroll
            for (int m = 0; m < 4; ++m) {
                const int row = u.pm * BM + ai * HALF + wr * 64 + m * 16 + fr - rsub;
                const float sc = rs[row];
                bf16_t* rowp = T + (size_t)row * pitch + col0;
                f32x4 cs0 = {1.f, 0.f, 1.f, 0.f}, cs1 = {1.f, 0.f, 1.f, 0.f};
                if (typ <= 1) { const f32x4* tp = (const f32x4*)(tab + (size_t)row * 64 + 2 * (16 * (wc & 1) + 4 * fq)); cs0 = tp[0]; cs1 = tp[1]; }
#pragma unroll
                for (int bj = 0; bj < 2; ++bj) {
                    f32x4 v0 = acc[ai][bj][m][0] * sc, v1 = acc[ai][bj][m][1] * sc;
                    if (typ <= 1) {
                        const f32x4 c = {cs0[0], cs0[2], cs1[0], cs1[2]}, s = {cs0[1], cs0[3], cs1[1], cs1[3]};
                        const f32x4 lo = v0 * c - v1 * s, hi = v0 * s + v1 * c;
                        v0 = lo; v1 = hi;
                        if (typ == 0) { v0 = v0 * QSCALE; v1 = v1 * QSCALE; }
                    } else if (typ == 4) {
#pragma unroll
                        for (int e = 0; e < 4; ++e) { v0[e] = gelu_tanh_f(v0[e]); v1[e] = gelu_tanh_f(v1[e]); }
                    }
                    u32x2 w0, w1; w0.x = cvt_pk_bf16(v0[0], v0[1]); w0.y = cvt_pk_bf16(v0[2], v0[3]); w1.x = cvt_pk_bf16(v1[0], v1[1]); w1.y = cvt_pk_bf16(v1[2], v1[3]);
                    *(u32x2*)(rowp + bj * HALF) = w0; *(u32x2*)(rowp + bj * HALF + 32) = w1;
                }
            }
    }
};

struct EpiRes {
    static constexpr bool AFTER_DRAIN = false;
    __host__ __device__ static __forceinline__ int perm_row(int R) { return perm_id(R); }
    const float* base; float* out; bf16_t* outb; float* ssq;
    __device__ __forceinline__ void operator()(const f32x4 (&acc)[2][2][4][2], const Unit& u, int wr, int wc, int fr, int fq) const {
#pragma unroll
        for (int ai = 0; ai < 2; ++ai)
#pragma unroll
            for (int m = 0; m < 4; ++m) {
                const int row = u.pm * BM + ai * HALF + wr * 64 + m * 16 + fr;
                const size_t off = (size_t)row * 1024 + u.pn * BM + wc * 32 + 4 * fq;
                float q = 0.f;
#pragma unroll
                for (int bj = 0; bj < 2; ++bj)
#pragma unroll
                    for (int n = 0; n < 2; ++n) {
                        const f32x4 bs = *(const f32x4*)(base + off + bj * HALF + n * 16);
                        const f32x4 o = bs + acc[ai][bj][m][n];
                        *(f32x4*)(out + off + bj * HALF + n * 16) = o;
                        q += (o[0] * o[0] + o[1] * o[1]) + (o[2] * o[2] + o[3] * o[3]);
                        if (outb) { u32x2 w; w.x = cvt_pk_bf16(o[0], o[1]); w.y = cvt_pk_bf16(o[2], o[3]); *(u32x2*)(outb + off + bj * HALF + n * 16) = w; }
                    }
                q += __shfl_xor(q, 16); q += __shfl_xor(q, 32);
                if (ssq && fq == 0) ssq[(size_t)row * 16 + u.pn * 4 + wc] = q;
                if (m & 1) asm volatile("" ::: "memory");
            }
    }
};

struct EpiSoftmax {
    static constexpr bool AFTER_DRAIN = true;
    __host__ __device__ static __forceinline__ int perm_row(int R) { return perm_std(R); }
    const float* ssq; bf16_t* P;
    __device__ __forceinline__ void fused(f32x4 (&acc)[2][2][4][2], const Unit& u, int wr, int wc, int fr, int fq, PG8_LAS unsigned char* lds, int wid, int lane) const {
        PG8_LAS float* PM = (PG8_LAS float*)lds;
        PG8_LAS float* PS = (PG8_LAS float*)(lds + 4096);
#pragma unroll
        for (int ai = 0; ai < 2; ++ai)
#pragma unroll
            for (int m = 0; m < 4; ++m) {
                const int rt = ai * HALF + wr * 64 + m * 16 + fr;
                const float sc = rstd_from_ssq16(ssq + (size_t)(u.pm * BM + rt) * 16);
                float mx = -3.0e38f;
#pragma unroll
                for (int bj = 0; bj < 2; ++bj)
#pragma unroll
                    for (int n = 0; n < 2; ++n) { f32x4 v = acc[ai][bj][m][n] * sc; acc[ai][bj][m][n] = v; mx = fmaxf(mx, fmaxf(fmaxf(v[0], v[1]), fmaxf(v[2], v[3]))); }
                mx = fmaxf(mx, __shfl_xor(mx, 16)); mx = fmaxf(mx, __shfl_xor(mx, 32));
                if (fq == 0) PM[rt * 4 + wc] = mx;
            }
        asm volatile("s_waitcnt lgkmcnt(0)" ::: "memory"); __builtin_amdgcn_s_barrier(); asm volatile("" ::: "memory");
#pragma unroll
        for (int ai = 0; ai < 2; ++ai)
#pragma unroll
            for (int m = 0; m < 4; ++m) {
                const int rt = ai * HALF + wr * 64 + m * 16 + fr;
                const f32x4 pm4 = *(const PG8_LAS f32x4*)(PM + rt * 4);
                const float mx = fmaxf(fmaxf(pm4[0], pm4[1]), fmaxf(pm4[2], pm4[3]));
                float s = 0.f;
#pragma unroll
                for (int bj = 0; bj < 2; ++bj)
#pragma unroll
                    for (int n = 0; n < 2; ++n) { f32x4 v = acc[ai][bj][m][n];
#pragma unroll
                        for (int e = 0; e < 4; ++e) v[e] = __builtin_amdgcn_exp2f(v[e] - mx);
                        acc[ai][bj][m][n] = v; s += (v[0] + v[1]) + (v[2] + v[3]); }
                s += __shfl_xor(s, 16); s += __shfl_xor(s, 32);
                if (fq == 0) PS[rt * 4 + wc] = s;
            }
        asm volatile("s_waitcnt lgkmcnt(0)" ::: "memory"); __builtin_amdgcn_s_barrier(); asm volatile("" ::: "memory");
#pragma unroll
        for (int ai = 0; ai < 2; ++ai)
#pragma unroll
            for (int m = 0; m < 4; ++m) {
                const int rt = ai * HALF + wr * 64 + m * 16 + fr;
                const f32x4 ps4 = *(const PG8_LAS f32x4*)(PS + rt * 4);
                const float inv = 1.0f / ((ps4[0] + ps4[1]) + (ps4[2] + ps4[3]));
                bf16_t* rowp = P + (size_t)(u.pm * BM + rt) * 1024 + u.pn * BM + wc * 32 + 8 * fq;
#pragma unroll
                for (int bj = 0; bj < 2; ++bj) { const f32x4 v0 = acc[ai][bj][m][0] * inv, v1 = acc[ai][bj][m][1] * inv;
                    u32x4 w; w.x = cvt_pk_bf16(v0[0], v0[1]); w.y = cvt_pk_bf16(v0[2], v0[3]); w.z = cvt_pk_bf16(v1[0], v1[1]); w.w = cvt_pk_bf16(v1[2], v1[3]);
                    *(u32x4*)(rowp + bj * HALF) = w; }
            }
    }
};

struct EpiMlpIn {
    static constexpr bool AFTER_DRAIN = false;
    __host__ __device__ static __forceinline__ int perm_row(int R) { return perm_std(R); }
    const float* ssq; bf16_t* H;
    __device__ __forceinline__ void operator()(const f32x4 (&acc)[2][2][4][2], const Unit& u, int wr, int wc, int fr, int fq) const {
#pragma unroll
        for (int ai = 0; ai < 2; ++ai)
#pragma unroll
            for (int m = 0; m < 4; ++m) {
                const int row = u.pm * BM + ai * HALF + wr * 64 + m * 16 + fr;
                const float sc = rstd_from_ssq16(ssq + (size_t)row * 16);
                bf16_t* rowp = H + (size_t)row * 4096 + u.pn * BM + wc * 32 + 8 * fq;
#pragma unroll
                for (int bj = 0; bj < 2; ++bj) {
                    f32x4 v0 = acc[ai][bj][m][0] * sc, v1 = acc[ai][bj][m][1] * sc;
#pragma unroll
                    for (int e = 0; e < 4; ++e) { const float a = fmaxf(v0[e], 0.f), b = fmaxf(v1[e], 0.f); v0[e] = a * a; v1[e] = b * b; }
                    u32x4 w; w.x = cvt_pk_bf16(v0[0], v0[1]); w.y = cvt_pk_bf16(v0[2], v0[3]); w.z = cvt_pk_bf16(v1[0], v1[1]); w.w = cvt_pk_bf16(v1[2], v1[3]);
                    *(u32x4*)(rowp + bj * HALF) = w;
                }
            }
    }
};

template <class Epi, class Sched, bool ALIGN_EPI = false, bool SP2 = false>
__device__ __forceinline__ void gemm_phase(PG8_LAS unsigned char* lds, const Gemm g, const Sched& S, const Epi& E, int wid_) {
    const int wid = wid_, lane = (int)__builtin_amdgcn_mbcnt_hi(~0u, __builtin_amdgcn_mbcnt_lo(~0u, 0u)), tid = wid * 64 + lane, wr = wid >> 2, wc = wid & 3, fr = lane & 15, fq = lane >> 4;
    const int K = g.K, nt = K / BK;
    unsigned voffA[2], voffB[2];
#pragma unroll
    for (int i = 0; i < 2; ++i) { int R, C; stage_rc(tid * 16 + i * 8192, R, C); const int Rb = Epi::perm_row(R);
        voffA[i] = (unsigned)(R * g.lda + C) * 2u; voffB[i] = (unsigned)(Rb * g.ldb + C) * 2u; }
    const size_t kstep = (size_t)(BK * 2);
    const size_t hstepA = (size_t)HALF * g.lda * 2, hstepB = (size_t)HALF * g.ldb * 2;
    const size_t tstepA = 2 * hstepA, tstepB = 2 * hstepB;
#define PG8_BASEA(u) ((const char*)g.A + (size_t)(u).pm * tstepA)
#define PG8_BASEB(u) ((const char*)g.Bt + (size_t)((u).pm >> g.bshift) * g.bstride + (size_t)(u).pn * tstepB)
    const unsigned ldsw = (unsigned)wid * 1024u;
    const int aoff = lds_byte(wr * 64 + fr, fq * 8), boff = lds_byte(wc * 32 + fr, fq * 8);
#define PG8_SA(b, h) (((b) * 2 + (h)) * HTB)
#define PG8_SB(b, h) ((4 + (b) * 2 + (h)) * HTB)
#define PG8_STAGE(bufoff, gbase, voff) do { _Pragma("unroll") for (int _i = 0; _i < 2; ++_i) \
        __builtin_amdgcn_global_load_lds((const unsigned*)((const char*)(gbase) + (voff)[_i]), (PG8_LAS unsigned*)(lds + (bufoff) + ldsw + _i * 8192), 16, 0, 0); } while (0)
#define PG8_LDA(dst, b, h) do { _Pragma("unroll") for (int m = 0; m < 4; ++m) _Pragma("unroll") for (int k = 0; k < 2; ++k) dst[m][k] = *(const PG8_LAS bf16x8*)(lds + PG8_SA(b, h) + aoff + m * 2048 + k * 1024); } while (0)
#define PG8_LDB(dst, b, h) do { _Pragma("unroll") for (int n = 0; n < 2; ++n) _Pragma("unroll") for (int k = 0; k < 2; ++k) dst[n][k] = *(const PG8_LAS bf16x8*)(lds + PG8_SB(b, h) + boff + n * 2048 + k * 1024); } while (0)
#define PG8_MMA(ai, bj, At, Bt) do { __builtin_amdgcn_s_setprio(1); _Pragma("unroll") for (int m = 0; m < 4; ++m) _Pragma("unroll") for (int n = 0; n < 2; ++n) _Pragma("unroll") for (int k = 0; k < 2; ++k) \
        acc[ai][bj][m][n] = __builtin_amdgcn_mfma_f32_16x16x32_bf16(Bt[n][k], At[m][k], acc[ai][bj][m][n], 0, 0, 0); __builtin_amdgcn_s_setprio(0); } while (0)
#define PG8_WAIT_V(n) asm volatile("s_waitcnt vmcnt(" #n ")" ::: "memory")
#define PG8_WAIT_L(n) asm volatile("s_waitcnt lgkmcnt(" #n ")" ::: "memory")
#define PG8_BAR __builtin_amdgcn_s_barrier()
#define PG8_SCHED __builtin_amdgcn_sched_barrier(0)
    Unit cur, nxt; int ui = 0;
    if (!S.next(0, cur)) return;
    f32x4 acc[2][2][4][2];
#pragma unroll
    for (int a = 0; a < 2; ++a)
#pragma unroll
        for (int b = 0; b < 2; ++b)
#pragma unroll
            for (int m = 0; m < 4; ++m)
#pragma unroll
                for (int n = 0; n < 2; ++n) acc[a][b][m][n] = (f32x4){0.f, 0.f, 0.f, 0.f};
    bf16x8 At[4][2], B0[2][2], B1[2][2];
    const char* cA = PG8_BASEA(cur); const char* cB = PG8_BASEB(cur);
    S.a_ready(cur);
    if constexpr (SP2) {
        PG8_STAGE(PG8_SB(0, 0), cB, voffB); PG8_STAGE(PG8_SB(0, 1), cB + hstepB, voffB); PG8_STAGE(PG8_SA(0, 0), cA, voffA); PG8_STAGE(PG8_SA(0, 1), cA + hstepA, voffA);
        if (wr == 1) PG8_BAR;
        PG8_WAIT_V(2); PG8_BAR;
        PG8_STAGE(PG8_SB(1, 0), cB + kstep, voffB); PG8_STAGE(PG8_SA(1, 0), cA + kstep, voffA); PG8_STAGE(PG8_SB(1, 1), cB + hstepB + kstep, voffB);
        PG8_WAIT_V(6); PG8_BAR;
    } else {
        PG8_STAGE(PG8_SB(0, 0), cB, voffB); PG8_STAGE(PG8_SA(0, 0), cA, voffA); PG8_STAGE(PG8_SB(0, 1), cB + hstepB, voffB); PG8_STAGE(PG8_SA(0, 1), cA + hstepA, voffA);
        if (wr == 1) PG8_BAR;
        PG8_WAIT_V(4); PG8_BAR;
        PG8_STAGE(PG8_SB(1, 0), cB + kstep, voffB); PG8_STAGE(PG8_SA(1, 0), cA + kstep, voffA); PG8_STAGE(PG8_SB(1, 1), cB + hstepB + kstep, voffB);
        PG8_WAIT_V(6); PG8_BAR;
    }
    for (;;) {
        const bool has_next = S.next(ui + 1, nxt);
        const char* nA = has_next ? PG8_BASEA(nxt) : cA; const char* nB = has_next ? PG8_BASEB(nxt) : cB;
        for (int t = 0; t < nt; t += 2) {
            const bool last = (t == nt - 2);
            const char* a1 = cA + (size_t)(t + 1) * kstep;
            const char* a2 = last ? nA : cA + (size_t)(t + 2) * kstep; const char* b2 = last ? nB : cB + (size_t)(t + 2) * kstep;
            const char* a3 = a2 + kstep; const char* b3 = b2 + kstep;
            if (last && has_next) S.a_ready(nxt);
            if constexpr (SP2) {
            PG8_LDB(B0, 0, 0); PG8_LDB(B1, 0, 1); PG8_SCHED; PG8_LDA(At, 0, 0); PG8_STAGE(PG8_SA(1, 1), a1 + hstepA, voffA);
            PG8_WAIT_V(8); PG8_WAIT_L(0); PG8_BAR; PG8_MMA(0, 0, At, B0); PG8_MMA(0, 1, At, B1); PG8_BAR; PG8_SCHED;
            PG8_LDA(At, 0, 1); PG8_STAGE(PG8_SB(0, 0), b2, voffB); PG8_STAGE(PG8_SB(0, 1), b2 + hstepB, voffB); PG8_STAGE(PG8_SA(0, 0), a2, voffA);
            PG8_WAIT_V(8); PG8_WAIT_L(0); PG8_BAR; PG8_MMA(1, 0, At, B0); PG8_MMA(1, 1, At, B1); PG8_BAR; PG8_SCHED;
            PG8_LDB(B0, 1, 0); PG8_LDB(B1, 1, 1); PG8_SCHED; PG8_LDA(At, 1, 0); PG8_STAGE(PG8_SA(0, 1), a2 + hstepA, voffA);
            PG8_WAIT_V(8); PG8_WAIT_L(0); PG8_BAR; PG8_MMA(0, 0, At, B0); PG8_MMA(0, 1, At, B1); PG8_BAR; PG8_SCHED;
            PG8_LDA(At, 1, 1); PG8_STAGE(PG8_SB(1, 0), b3, voffB); PG8_STAGE(PG8_SB(1, 1), b3 + hstepB, voffB); PG8_STAGE(PG8_SA(1, 0), a3, voffA);
            PG8_WAIT_V(8); PG8_WAIT_L(0); PG8_BAR; PG8_MMA(1, 0, At, B0); PG8_MMA(1, 1, At, B1); PG8_BAR; PG8_SCHED;
            } else {
            PG8_LDB(B0, 0, 0); PG8_SCHED; PG8_LDA(At, 0, 0); PG8_STAGE(PG8_SA(1, 1), a1 + hstepA, voffA);
            PG8_WAIT_L(8); PG8_BAR; PG8_WAIT_L(0); PG8_MMA(0, 0, At, B0); PG8_BAR; PG8_SCHED;
            PG8_LDB(B1, 0, 1); PG8_STAGE(PG8_SB(0, 0), b2, voffB);
            PG8_BAR; PG8_WAIT_L(0); PG8_MMA(0, 1, At, B1); PG8_BAR;
            PG8_LDA(At, 0, 1); PG8_STAGE(PG8_SA(0, 0), a2, voffA);
            PG8_BAR; PG8_WAIT_L(0); PG8_MMA(1, 0, At, B0); PG8_BAR; PG8_SCHED;
            PG8_STAGE(PG8_SB(0, 1), b2 + hstepB, voffB);
            PG8_WAIT_V(6); PG8_BAR; PG8_MMA(1, 1, At, B1); PG8_BAR;
            PG8_LDB(B0, 1, 0); PG8_SCHED; PG8_LDA(At, 1, 0); PG8_STAGE(PG8_SA(0, 1), a2 + hstepA, voffA);
            PG8_WAIT_L(8); PG8_BAR; PG8_WAIT_L(0); PG8_MMA(0, 0, At, B0); PG8_BAR; PG8_SCHED;
            PG8_LDB(B1, 1, 1); PG8_STAGE(PG8_SB(1, 0), b3, voffB);
            PG8_BAR; PG8_WAIT_L(0); PG8_MMA(0, 1, At, B1); PG8_BAR;
            PG8_LDA(At, 1, 1); PG8_STAGE(PG8_SA(1, 0), a3, voffA);
            PG8_BAR; PG8_WAIT_L(0); PG8_MMA(1, 0, At, B0); PG8_BAR; PG8_SCHED;
            PG8_STAGE(PG8_SB(1, 1), b3 + hstepB, voffB);
            PG8_WAIT_V(6); PG8_BAR; PG8_MMA(1, 1, At, B1); PG8_BAR;
            }
        }
        if constexpr (ALIGN_EPI) { if (wr == 0) PG8_BAR; }
        if constexpr (!Epi::AFTER_DRAIN) { E(acc, cur, wr, wc, fr, fq); S.done(cur); }
        if (!has_next) break;
#pragma unroll
        for (int a = 0; a < 2; ++a)
#pragma unroll
            for (int b = 0; b < 2; ++b)
#pragma unroll
                for (int m = 0; m < 4; ++m)
#pragma unroll
                    for (int n = 0; n < 2; ++n) acc[a][b][m][n] = (f32x4){0.f, 0.f, 0.f, 0.f};
        cur = nxt; cA = nA; cB = nB; ++ui;
        if constexpr (ALIGN_EPI) { if (wr == 1) PG8_BAR; }
    }
    PG8_WAIT_V(0);
    if constexpr (!ALIGN_EPI) { if (wr == 0) PG8_BAR; }
    PG8_BAR;
    if constexpr (Epi::AFTER_DRAIN) { E.fused(acc, cur, wr, wc, fr, fq, lds, wid, lane); S.done(cur); }
#undef PG8_BASEA
#undef PG8_BASEB
#undef PG8_SA
#undef PG8_SB
#undef PG8_STAGE
#undef PG8_LDA
#undef PG8_LDB
#undef PG8_MMA
#undef PG8_WAIT_V
#undef PG8_WAIT_L
#undef PG8_BAR
#undef PG8_SCHED
}
}

constexpr int NWAVES = 8;
#ifndef MK_N_LAUNCHES
#define MK_N_LAUNCHES 1
#endif
constexpr int N_PHASES = 10;
constexpr int N_LAUNCHES = MK_N_LAUNCHES;

constexpr size_t MiB = 1u << 20, KiB = 1u << 10;
constexpr size_t WS_CTL = 0, CTL_ZERO_BYTES = 32 * KiB;
constexpr size_t WS_RS0 = 1 * MiB, WS_RSM = 1 * MiB + 64 * KiB;
constexpr size_t WS_SSQ1 = 2 * MiB, WS_SSQ2 = 3 * MiB;
constexpr size_t WS_SUMM = 4 * MiB;
constexpr size_t WS_TAB = 6 * MiB;
constexpr size_t WS_WIN = 10 * MiB, WS_WCKV = 15 * MiB;
constexpr size_t WS_WOUT = 17 * MiB, WS_WCQN = 19 * MiB, WS_WCO = 20 * MiB;
constexpr size_t WS_WMI = 21 * MiB, WS_WMO = 29 * MiB;
constexpr size_t WS_BTS = 37 * MiB, WS_BTO = 45 * MiB;
constexpr size_t WS_KVM = 53 * MiB, WS_RGW = 55 * MiB;
constexpr size_t WS_XB = 56 * MiB, WS_MEMB = 88 * MiB;
constexpr size_t WS_MIX = 90 * MiB;
constexpr size_t WS_Q = 122 * MiB, WS_K = 138 * MiB, WS_V = 154 * MiB, WS_U = 170 * MiB, WS_G = 186 * MiB;
constexpr size_t WS_OP = 202 * MiB;
constexpr size_t WS_HID = 122 * MiB;
constexpr size_t WS_LSE = 250 * MiB;
constexpr size_t WS_END = 252 * MiB;
static_assert(WS_WIN + (size_t)2560 * 1024 * 2 == WS_WCKV && WS_XB + (size_t)NT * 1024 * 2 == WS_MEMB && WS_HID + (size_t)NT * FF * 2 == WS_LSE, "d_ws map");
constexpr int CW_BAR = 4096;

constexpr int RING_OFF = 0, RING_BYTES = 131072;
constexpr int SCRATCH_BYTES = 139264;
constexpr int LDSCTL_OFF = SCRATCH_BYTES, MISC_OFF = LDSCTL_OFF + 320;
constexpr int LDS_BYTES = SCRATCH_BYTES + 1024;
static_assert(MISC_OFF + 128 <= LDS_BYTES, "LDS map");

#define GAS __attribute__((address_space(1)))
#define LAS __attribute__((address_space(3)))
typedef unsigned short bf16;
typedef unsigned v4u __attribute__((ext_vector_type(4)));
typedef float f32x4 __attribute__((ext_vector_type(4)));
typedef GAS unsigned gu32;
#define RLX_AGENT __ATOMIC_RELAXED, __HIP_MEMORY_SCOPE_AGENT
#define LDS_WAIT() asm volatile("s_waitcnt lgkmcnt(0)" ::: "memory")
#define VM_WAIT() asm volatile("s_waitcnt vmcnt(0)" ::: "memory")
__device__ __forceinline__ unsigned f2bf(float f) { unsigned u = __builtin_bit_cast(unsigned, f); return (u + 0x7fffu + ((u >> 16) & 1u)) >> 16; }
__device__ __forceinline__ unsigned pk2(float lo, float hi) { return f2bf(lo) | (f2bf(hi) << 16); }
__device__ __forceinline__ float bf2f(unsigned short b) { return __builtin_bit_cast(float, (unsigned)b << 16); }
__device__ __forceinline__ float bflo(unsigned w) { return __builtin_bit_cast(float, w << 16); }
__device__ __forceinline__ float bfhi(unsigned w) { return __builtin_bit_cast(float, w & 0xffff0000u); }

#define XB_TMO      128
#define XB_XCNT(j)  (256  + 64 * (j))
#define XB_XSUB(j)  (1280 + 64 * (j))
#define XB_XGEN(j)  (2304 + 64 * (j))
#define XB_TOP      3328
#define XB_TOPGEN   3392
#define XCD_BAR_WORDS 3456
#define XB_SPIN_CAP (1u << 18)

__device__ __forceinline__ unsigned xb_ld(unsigned* p)              { return __hip_atomic_load(p, __ATOMIC_RELAXED, __HIP_MEMORY_SCOPE_AGENT); }
__device__ __forceinline__ unsigned xb_add(unsigned* p, unsigned v) { return __hip_atomic_fetch_add(p, v, __ATOMIC_RELAXED, __HIP_MEMORY_SCOPE_AGENT); }
__device__ __forceinline__ unsigned xb_xcc_id() { return (unsigned)__builtin_amdgcn_s_getreg((3 << 11) | 20) & 0xFu; }
#define XB_SPIN(cond, bar) do { unsigned _sp = 0; while (cond) { __builtin_amdgcn_s_sleep(1); \
    if ((++_sp & 255u) == 0u) { if (xb_ld(&(bar)[XB_TMO])) break; if (_sp > XB_SPIN_CAP) { atomicAdd(&(bar)[XB_TMO], 1u); break; } } } } while (0)

struct XcdBarrier {
    unsigned* bar; unsigned x;
    volatile LAS unsigned* st;
};
__device__ __forceinline__ XcdBarrier xcd_barrier_post(unsigned* bar, volatile LAS unsigned* st, bool tid0) {
    XcdBarrier b; b.bar = bar; b.x = xb_xcc_id(); b.st = st;
    if (tid0) (void)xb_add(&bar[XB_XCNT(b.x)], 1u);
    return b;
}
__device__ __forceinline__ void xcd_barrier_complete(unsigned* bar, unsigned x, unsigned& nloc, unsigned& nx) {
    const unsigned G = gridDim.x * gridDim.y * gridDim.z;
    unsigned sum, cnt, mine, sp = 0u;
    for (;;) {
        sum = 0u; cnt = 0u; mine = 0u;
#pragma unroll
        for (unsigned j = 0; j < 16; ++j) { const unsigned c = xb_ld(&bar[XB_XCNT(j)]); sum += c; cnt += (c > 0u) ? 1u : 0u; mine = (j == x) ? c : mine; }
        if (sum == G) break;
        __builtin_amdgcn_s_sleep(1);
        if ((++sp & 255u) == 0u) { if (xb_ld(&bar[XB_TMO])) break; if (sp > XB_SPIN_CAP) { atomicAdd(&bar[XB_TMO], 1u); break; } }
    }
    nloc = mine > 0u ? mine : 1u; nx = cnt > 0u ? cnt : 1u;
}
__device__ __forceinline__ void xcd_barrier(const XcdBarrier& b, bool tid0) {
    asm volatile("s_waitcnt vmcnt(0)" ::: "memory");
    __syncthreads();
    if (tid0) {
        unsigned* bar = b.bar;
        __builtin_amdgcn_s_waitcnt(0);
        unsigned nloc = b.st[0], nx = b.st[1];
        if (nloc == 0u) { xcd_barrier_complete(bar, b.x, nloc, nx); b.st[0] = nloc; b.st[1] = nx; }
        const unsigned old = xb_add(&bar[XB_XSUB(b.x)], 1u);
        const unsigned gen = old / nloc;
        if (old + 1u == (gen + 1u) * nloc) {
            __builtin_amdgcn_fence(__ATOMIC_RELEASE, "agent");
            asm volatile("s_waitcnt vmcnt(0)" ::: "memory");
            const unsigned og = xb_add(&bar[XB_TOP], 1u);
            const unsigned tg = og / nx;
            if (og + 1u == (tg + 1u) * nx) xb_add(&bar[XB_TOPGEN], 1u);
            else XB_SPIN(xb_ld(&bar[XB_TOPGEN]) == tg, bar);
            __builtin_amdgcn_fence(__ATOMIC_ACQUIRE, "agent");
            xb_add(&bar[XB_XGEN(b.x)], 1u);
            asm volatile("s_waitcnt vmcnt(0)" ::: "memory");
        } else {
            XB_SPIN(xb_ld(&bar[XB_XGEN(b.x)]) == gen, bar);
            __builtin_amdgcn_fence(__ATOMIC_ACQUIRE, "agent");
            asm volatile("s_waitcnt vmcnt(0)" ::: "memory");
        }
    }
    __syncthreads();
}

struct Frame {
    LAS unsigned char* lds;
    volatile LAS unsigned* MISC;
    gu32* ctl;
    int tid, lane, wave;
    int vcu, G;
    unsigned char* ws;
    const float* x; const float* mem; const int* pos; float* out;
    const float *g_mix, *w_in, *conv_w, *conv_b, *a_w, *a_b, *x_w, *x_b, *lam, *w_out, *g_cross, *g_mem, *w_cq, *w_ck, *w_cv, *w_co, *g_mlp, *w_mi, *w_mo, *g_fin;
};
template <class T> __device__ __forceinline__ T* wsp(const Frame& F, size_t off) { return (T*)(F.ws + off); }

__device__ __forceinline__ float wave_sum(float v) {
#pragma unroll
    for (int o = 1; o < 64; o <<= 1) v += __shfl_xor(v, o);
    return v;
}
__device__ __forceinline__ float wave_max(float v) {
#pragma unroll
    for (int o = 1; o < 64; o <<= 1) v = fmaxf(v, __shfl_xor(v, o));
    return v;
}

__device__ __forceinline__ void p0_transpose_item(const float* W, const float* gain, int K, int N, bf16* WT, int row_off, LAS float* scr, int item, int lane) {
    const int nblk = N / 32, kb = item / nblk, nb = item % nblk, k0 = 64 * kb, n0 = 32 * nb;
#pragma unroll 8
    for (int i = 0; i < 32; ++i) { const int kk = 2 * i + (lane >> 5); const float gv = gain ? gain[k0 + kk] : 1.f; scr[kk * 33 + (lane & 31)] = W[(size_t)(k0 + kk) * N + n0 + (lane & 31)] * gv; }
    LDS_WAIT(); asm volatile("" ::: "memory");
    const int c = lane & 7;
#pragma unroll
    for (int j = 0; j < 4; ++j) { const int n = (lane >> 3) + 8 * j; const LAS float* s = scr + (8 * c) * 33 + n;
        v4u o; o.x = pk2(s[0 * 33], s[1 * 33]); o.y = pk2(s[2 * 33], s[3 * 33]); o.z = pk2(s[4 * 33], s[5 * 33]); o.w = pk2(s[6 * 33], s[7 * 33]);
        *(GAS v4u*)(WT + (size_t)(row_off + n0 + n) * K + k0 + 8 * c) = o; }
    LDS_WAIT(); asm volatile("" ::: "memory");
}
__device__ __forceinline__ void row_to_bf16_rs(int lane, const float* xrow, bf16* orow, float* rs) {
    const GAS f32x4* xr = (const GAS f32x4*)xrow + lane;
    f32x4 v[4]; float s = 0.f;
#pragma unroll
    for (int j = 0; j < 4; ++j) { v[j] = xr[64 * j]; s += (v[j].x * v[j].x + v[j].y * v[j].y) + (v[j].z * v[j].z + v[j].w * v[j].w); }
    s = wave_sum(s);
    if (lane == 0) *rs = 1.0f / sqrtf(s * (1.f / DM) + NORM_EPS);
    GAS unsigned long long* o8 = (GAS unsigned long long*)orow + lane;
#pragma unroll
    for (int j = 0; j < 4; ++j) o8[64 * j] = (unsigned long long)pk2(v[j].x, v[j].y) | ((unsigned long long)pk2(v[j].z, v[j].w) << 32);
}
__device__ __forceinline__ void p0_prologue(Frame& F) {
    LAS float* scr = (LAS float*)(F.lds + RING_OFF + F.wave * 16384);
    const int gw = F.vcu * NWAVES + F.wave, NGW = F.G * NWAVES, lane = F.lane;
    bf16* WIN = wsp<bf16>(F, WS_WIN); bf16* WCKV = wsp<bf16>(F, WS_WCKV); bf16* WOUT = wsp<bf16>(F, WS_WOUT); bf16* WCO = wsp<bf16>(F, WS_WCO);
    bf16* WMI = wsp<bf16>(F, WS_WMI); bf16* WMO = wsp<bf16>(F, WS_WMO);
    constexpr int I_IN = 16 * 80, I_CK = 16 * 16, I_OUT = 16 * 32, I_CO = 8 * 32, I_MI = 16 * 128, I_MO = 64 * 32;
    constexpr int NITEMS = I_IN + 2 * I_CK + I_OUT + I_CO + I_MI + I_MO;
    for (int it = gw; it < NITEMS; it += NGW) {
        int r = it;
        if (r < I_MI) { p0_transpose_item(F.w_mi, F.g_mlp, DM, FF, WMI, 0, scr, r, lane); continue; } r -= I_MI;
        if (r < I_MO) { p0_transpose_item(F.w_mo, nullptr, FF, DM, WMO, 0, scr, r, lane); continue; } r -= I_MO;
        if (r < I_IN) { p0_transpose_item(F.w_in, F.g_mix, DM, 2560, WIN, 0, scr, r, lane); continue; } r -= I_IN;
        if (r < I_CK) { p0_transpose_item(F.w_ck, F.g_mem, DM, 512, WCKV, 0, scr, r, lane); continue; } r -= I_CK;
        if (r < I_CK) { p0_transpose_item(F.w_cv, F.g_mem, DM, 512, WCKV, 512, scr, r, lane); continue; } r -= I_CK;
        if (r < I_OUT) { p0_transpose_item(F.w_out, nullptr, DM, DM, WOUT, 0, scr, r, lane); continue; } r -= I_OUT;
        p0_transpose_item(F.w_co, nullptr, 512, DM, WCO, 0, scr, r, lane);
    }
    { bf16* WCQN = wsp<bf16>(F, WS_WCQN); const int gt = gw * 64 + lane, NGT = NGW * 64;
      for (int i = gt; i < 1024 * 512 / 4; i += NGT) { const int k = i >> 7; const f32x4 v = ((const GAS f32x4*)F.w_cq)[i]; const float g = F.g_cross[k];
          ((GAS unsigned long long*)WCQN)[i] = (unsigned long long)pk2(v.x * g, v.y * g) | ((unsigned long long)pk2(v.z * g, v.w * g) << 32); } }
    { bf16* RGW = wsp<bf16>(F, WS_RGW); const int gt = gw * 64 + lane, NGT = NGW * 64;
      for (int i = gt; i < 2 * 2 * 8 * 64 * 64; i += NGT) { const int ii = i & 63, jo = (i >> 6) & 63, gg = (i >> 12) & 7, dir = (i >> 15) & 1, ty = i >> 16; const float* W = ty ? F.x_w : F.a_w;
          RGW[i] = (bf16)f2bf(W[((size_t)(dir * 8 + gg) * 64 + ii) * 64 + jo]); } }
    { float* TAB = wsp<float>(F, WS_TAB); const int gt = gw * 64 + lane, NGT = NGW * 64;
      for (int i = gt; i < NT * 32; i += NGT) { const int tok = i >> 5, d = i & 31; const float inv = powf(10000.f, -(float)d / 32.f); const float ang = (float)F.pos[tok] * inv;
          float sn, cs; sincosf(ang, &sn, &cs); ((float2*)TAB)[i] = make_float2(cs, sn); } }
    bf16* XB = wsp<bf16>(F, WS_XB); bf16* MEMB = wsp<bf16>(F, WS_MEMB); float* RS0 = wsp<float>(F, WS_RS0); float* RSM = wsp<float>(F, WS_RSM);
    for (int m = gw; m < NT; m += NGW) row_to_bf16_rs(lane, F.x + (size_t)m * DM, XB + (size_t)m * DM, RS0 + m);
    for (int m = gw; m < NB * NMEM; m += NGW) row_to_bf16_rs(lane, F.mem + (size_t)m * DM, MEMB + (size_t)m * DM, RSM + m);
}

__device__ __forceinline__ float dot128_bf16(const bf16* a, const bf16* b) {
    float acc = 0.f;
#pragma unroll 4
    for (int c = 0; c < 16; ++c) { const v4u x = ((const GAS v4u*)a)[c], y = ((const GAS v4u*)b)[c];
        acc += bflo(x.x) * bflo(y.x) + bfhi(x.x) * bfhi(y.x) + bflo(x.y) * bflo(y.y) + bfhi(x.y) * bfhi(y.y) + bflo(x.z) * bflo(y.z) + bfhi(x.z) * bfhi(y.z) + bflo(x.w) * bflo(y.w) + bfhi(x.w) * bfhi(y.w); }
    return acc;
}
typedef short xw_bf16x8 __attribute__((ext_vector_type(8)));
typedef float xw_f32x16 __attribute__((ext_vector_type(16)));
__device__ __forceinline__ void xw_tile(const bf16* X, int ldx, const bf16* Y, int ldy, bf16* OUT, int ldo, float scale, int lane) {
    const int r32 = lane & 31, hi = lane >> 5;
    xw_f32x16 acc[2][2];
#pragma unroll
    for (int ci = 0; ci < 2; ++ci)
#pragma unroll
        for (int ri = 0; ri < 2; ++ri) acc[ci][ri] = (xw_f32x16){};
    const bf16* yp = Y + r32 * ldy + 8 * hi; const bf16* xp = X + r32 * ldx + 8 * hi;
#pragma unroll 2
    for (int s = 0; s < 8; ++s) {
        xw_bf16x8 ya[2], xb[2];
#pragma unroll
        for (int i = 0; i < 2; ++i) { ya[i] = *(const GAS xw_bf16x8*)(yp + 32 * i * ldy + 16 * s); xb[i] = *(const GAS xw_bf16x8*)(xp + 32 * i * ldx + 16 * s); }
#pragma unroll
        for (int ci = 0; ci < 2; ++ci)
#pragma unroll
            for (int ri = 0; ri < 2; ++ri) acc[ci][ri] = __builtin_amdgcn_mfma_f32_32x32x16_bf16(ya[ci], xb[ri], acc[ci][ri], 0, 0, 0);
    }
#pragma unroll
    for (int ci = 0; ci < 2; ++ci)
#pragma unroll
        for (int ri = 0; ri < 2; ++ri)
#pragma unroll
            for (int rq = 0; rq < 4; ++rq) {
                const int c = 32 * ci + 8 * rq + 4 * hi, r = 32 * ri + r32;
                const unsigned lo = pg8::cvt_pk_bf16(acc[ci][ri][4 * rq] * scale, acc[ci][ri][4 * rq + 1] * scale), hh = pg8::cvt_pk_bf16(acc[ci][ri][4 * rq + 2] * scale, acc[ci][ri][4 * rq + 3] * scale);
                *(GAS unsigned long long*)(OUT + (size_t)r * ldo + c) = (unsigned long long)lo | ((unsigned long long)hh << 32);
            }
}
__device__ __forceinline__ void p2_cross_weights(Frame& F) {
    const bf16* KVM = wsp<bf16>(F, WS_KVM); const bf16* WCQN = wsp<bf16>(F, WS_WCQN); const bf16* WCO = wsp<bf16>(F, WS_WCO);
    bf16* BTS = wsp<bf16>(F, WS_BTS); bf16* BTO = wsp<bf16>(F, WS_BTO);
    const int gw = F.vcu * NWAVES + F.wave, NGW = F.G * NWAVES;
    for (int u = gw; u < 2048; u += NGW) {
        int lane = F.lane; asm volatile("" : "+v"(lane));
        const int t = u & 1023, bh = t >> 6, b = bh >> 2, h = bh & 3, q = t & 63;
        if (u < 1024) { const int mt = q & 3, kt = q >> 2;
            xw_tile(KVM + (size_t)(b * NMEM + 64 * mt) * 1024 + h * 128, 1024, WCQN + (size_t)(64 * kt) * 512 + h * 128, 512, BTS + ((size_t)b * 1024 + h * 256 + 64 * mt) * 1024 + 64 * kt, 1024, CSCALE, lane); }
        else { const int mt = q & 3, nt = q >> 2;
            xw_tile(WCO + (size_t)(64 * nt) * 512 + h * 128, 512, KVM + (size_t)(b * NMEM + 64 * mt) * 1024 + 512 + h * 128, 1024, BTO + ((size_t)b * 1024 + 64 * nt) * 1024 + h * 256 + 64 * mt, 1024, 1.0f, lane); }
    }
}
__device__ __forceinline__ void p2_attn_simple(Frame& F) {
    const bf16* Q = wsp<bf16>(F, WS_Q); const bf16* K = wsp<bf16>(F, WS_K); const bf16* V = wsp<bf16>(F, WS_V); bf16* MIX = wsp<bf16>(F, WS_MIX);
    const int gw = F.vcu * NWAVES + F.wave, NGW = F.G * NWAVES, lane = F.lane;
    for (int u = gw; u < NT * 8; u += NGW) {
        const int h = u & 7, tok = u >> 3, b = tok >> 12, t = tok & (SEQ - 1);
        const float qd = bf2f(Q[(size_t)tok * 512 + h * 64 + lane]);
        float s[9];
#pragma unroll
        for (int pi = 0; pi < 3; ++pi) {
            const int dil = pi == 0 ? 1 : (pi == 1 ? 4 : 16);
#pragma unroll
            for (int r = 0; r < 3; ++r) {
                const int jj = r * 64 + lane, tk = t + (jj - 64) * dil;
                const bool val = (jj < 129) && tk >= 0 && tk < SEQ;
                const GAS v4u* kp = (const GAS v4u*)(K + (size_t)(b * SEQ + (val ? tk : t)) * 512 + h * 64);
                float acc = 0.f;
#pragma unroll
                for (int c = 0; c < 8; ++c) { const v4u x = kp[c];
                    acc += __shfl(qd, 8 * c + 0) * bflo(x.x) + __shfl(qd, 8 * c + 1) * bfhi(x.x) + __shfl(qd, 8 * c + 2) * bflo(x.y) + __shfl(qd, 8 * c + 3) * bfhi(x.y)
                         + __shfl(qd, 8 * c + 4) * bflo(x.z) + __shfl(qd, 8 * c + 5) * bfhi(x.z) + __shfl(qd, 8 * c + 6) * bflo(x.w) + __shfl(qd, 8 * c + 7) * bfhi(x.w); }
                s[pi * 3 + r] = val ? acc : -1e30f;
            }
        }
        float m = s[0];
#pragma unroll
        for (int i = 1; i < 9; ++i) m = fmaxf(m, s[i]);
        m = wave_max(m);
        float den = 0.f;
#pragma unroll
        for (int i = 0; i < 9; ++i) { s[i] = exp2f(s[i] - m); den += s[i]; }
        den = wave_sum(den);
        float o = 0.f;
#pragma unroll
        for (int pi = 0; pi < 3; ++pi) {
            const int dil = pi == 0 ? 1 : (pi == 1 ? 4 : 16);
            for (int jj = 0; jj < 129; ++jj) {
                const int tk = t + (jj - 64) * dil; const int r = jj >> 6;
                const float pr = r == 0 ? s[pi * 3] : (r == 1 ? s[pi * 3 + 1] : s[pi * 3 + 2]);
                const float pj = __shfl(pr, jj & 63);
                if (tk >= 0 && tk < SEQ) o += pj * bf2f(V[(size_t)(b * SEQ + tk) * 512 + h * 64 + lane]);
            }
        }
        MIX[(size_t)tok * 1024 + h * 64 + lane] = (bf16)f2bf(o / den);
    }
}

typedef short bf16x8_t __attribute__((ext_vector_type(8)));
typedef short s16x4_t __attribute__((ext_vector_type(4)));
typedef float f32x16_t __attribute__((ext_vector_type(16)));
constexpr int AT_NK = 384, AT_K_OFF = 0, AT_V_OFF = AT_NK * 128, AT_VH = AT_NK * 64 + 64, AT_WS_OFF = AT_V_OFF + 2 * AT_VH, AT_WS_PER_WAVE = 256 + 4096;
static_assert(AT_WS_OFF % 16 == 0 && AT_WS_OFF + NWAVES * AT_WS_PER_WAVE <= SCRATCH_BYTES, "attention LDS map");
__device__ __forceinline__ int crow16(int r, int hi) { return (r & 3) + 8 * (r >> 2) + 4 * hi; }
__device__ __forceinline__ void p2_attn_mfma(Frame& F) {
    const bf16* Q = wsp<bf16>(F, WS_Q); const bf16* K = wsp<bf16>(F, WS_K); const bf16* V = wsp<bf16>(F, WS_V);
    bf16* OP = wsp<bf16>(F, WS_OP); float* LSE = wsp<float>(F, WS_LSE);
    const int lane = F.lane, w = F.wave, r32 = lane & 31, hi = lane >> 5;
    LAS unsigned char* lds = F.lds;
    LAS float* wsf = (LAS float*)(lds + AT_WS_OFF + w * AT_WS_PER_WAVE);
    LAS bf16* stg = (LAS bf16*)(lds + AT_WS_OFF + w * AT_WS_PER_WAVE + 256);
    const int xcd = F.vcu >> 5, wl = F.vcu & 31;
    v4u kv[6], vv[6];
#define AT_DECODE(it_) const int uu = wl + 32 * (it_), bh = xcd * 4 + uu / 48, rem = uu % 48, pat = rem >> 4, blk = rem & 15; \
        const int b = bh >> 3, h = bh & 7; const int dil = pat == 0 ? 1 : (pat == 1 ? 4 : 16), L = SEQ / dil; \
        const int cls = pat == 0 ? 0 : (pat == 1 ? (blk >> 2) : blk), i0 = pat == 0 ? blk * 256 : (pat == 1 ? (blk & 3) * 256 : 0);
#define AT_PREFETCH(it_) do { AT_DECODE(it_) const bf16* Kb = K + (size_t)(b * SEQ + cls) * 512 + h * 64; const bf16* Vb = V + (size_t)(b * SEQ + cls) * 512 + h * 64; \
        _Pragma("unroll") for (int k = 0; k < 6; ++k) { const int idx = tid + 512 * k, row = idx >> 3, c = idx & 7, pos = i0 - 64 + row; const bool ok = pos >= 0 && pos < L; \
            const int off = (ok ? pos : 0) * dil * 512 + c * 8; \
            kv[k] = *(const GAS v4u*)(Kb + off); vv[k] = *(const GAS v4u*)(Vb + off); } } while (0)
    { const int tid = F.tid; AT_PREFETCH(0); }
    for (int it = 0; it < 6; ++it) {
        AT_DECODE(it)
        int tid = F.tid; asm volatile("" : "+v"(tid));
        const int qpos = i0 + 32 * w + r32;
        const size_t qtok = (size_t)(b * SEQ + qpos * dil + cls);
        bf16x8_t qr[4];
#pragma unroll
        for (int s = 0; s < 4; ++s) qr[s] = *(const GAS bf16x8_t*)(Q + qtok * 512 + h * 64 + 16 * s + 8 * hi);
#pragma unroll
        for (int k = 0; k < 6; ++k) {
            const int idx = tid + 512 * k, row = idx >> 3, c = idx & 7, pos = i0 - 64 + row;
            const bool ok = pos >= 0 && pos < L; const v4u z = {0u, 0u, 0u, 0u};
            *(LAS v4u*)(lds + AT_K_OFF + row * 128 + ((c ^ ((row >> 1) & 7)) << 4)) = ok ? kv[k] : z;
            *(LAS v4u*)(lds + AT_V_OFF + (c >> 2) * AT_VH + row * 64 + (c & 3) * 16) = ok ? vv[k] : z;
        }
        __syncthreads();
        AT_PREFETCH(it + 1 < 6 ? it + 1 : 5);
        f32x16_t S[5];
#pragma unroll
        for (int kt = 0; kt < 5; ++kt) {
            const int row = 32 * w + 32 * kt + r32;
            f32x16_t acc = {};
#pragma unroll
            for (int s = 0; s < 4; ++s) {
                const bf16x8_t kf = *(const LAS bf16x8_t*)(lds + AT_K_OFF + row * 128 + (((2 * s + hi) ^ ((row >> 1) & 7)) << 4));
                acc = __builtin_amdgcn_mfma_f32_32x32x16_bf16(kf, qr[s], acc, 0, 0, 0);
            }
            S[kt] = acc; __builtin_amdgcn_sched_barrier(0);
        }
        float mx = -1e30f;
#pragma unroll
        for (int kt = 0; kt < 5; ++kt)
#pragma unroll
            for (int r = 0; r < 16; ++r) {
                const int cr = crow16(r, hi), kpos = i0 - 64 + 32 * w + 32 * kt + cr;
                bool ok = kpos >= 0 && kpos < L;
                if (kt == 0) ok = ok && cr >= r32;
                if (kt == 4) ok = ok && cr <= r32;
                const float v = ok ? S[kt][r] : -1e30f;
                S[kt][r] = v; mx = fmaxf(mx, v);
            }
        mx = fmaxf(mx, __shfl_xor(mx, 32));
        float lsum = 0.f;
#pragma unroll
        for (int kt = 0; kt < 5; ++kt)
#pragma unroll
            for (int r = 0; r < 16; ++r) { const float p = __builtin_amdgcn_exp2f(S[kt][r] - mx); S[kt][r] = p; lsum += p; }
        lsum += __shfl_xor(lsum, 32);
        f32x16_t o[2]; o[0] = (f32x16_t){}; o[1] = (f32x16_t){};
        const int vlane = ((lane >> 4) & 1) * 32 + (lane & 3) * 8 + (4 * hi + ((lane & 15) >> 2)) * 64;
#pragma unroll
        for (int kt = 0; kt < 5; ++kt)
#pragma unroll
            for (int ss = 0; ss < 2; ++ss) {
                unsigned pw[4];
#pragma unroll
                for (int j = 0; j < 4; ++j) pw[j] = pg8::cvt_pk_bf16(S[kt][8 * ss + 2 * j], S[kt][8 * ss + 2 * j + 1]);
                const v4u pwv = {pw[0], pw[1], pw[2], pw[3]};
                const bf16x8_t pa = __builtin_bit_cast(bf16x8_t, pwv);
                const int rowb = (32 * w + 32 * kt + 16 * ss) * 64;
#pragma unroll
                for (int dh = 0; dh < 2; ++dh) {
                    LAS unsigned char* vp = lds + AT_V_OFF + dh * AT_VH + rowb + vlane;
                    const s16x4_t lo = __builtin_bit_cast(s16x4_t, __builtin_amdgcn_ds_read_tr16_b64_v4i16((LAS s16x4_t*)vp));
                    const s16x4_t hh = __builtin_bit_cast(s16x4_t, __builtin_amdgcn_ds_read_tr16_b64_v4i16((LAS s16x4_t*)(vp + 512)));
                    const bf16x8_t vf = {lo[0], lo[1], lo[2], lo[3], hh[0], hh[1], hh[2], hh[3]};
                    o[dh] = __builtin_amdgcn_mfma_f32_32x32x16_bf16(pa, vf, o[dh], 0, 0, 0);
                }
            }
        if (hi == 0) { wsf[r32] = lsum; LSE[((size_t)pat * NT + qtok) * 8 + h] = mx + __builtin_amdgcn_logf(lsum); }
        LDS_WAIT();
#pragma unroll
        for (int r = 0; r < 16; ++r) {
            const int qrow = crow16(r, hi); const float rl = __builtin_amdgcn_rcpf(wsf[qrow]);
            stg[qrow * 64 + r32] = (bf16)f2bf(o[0][r] * rl); stg[qrow * 64 + 32 + r32] = (bf16)f2bf(o[1][r] * rl);
        }
        LDS_WAIT();
#pragma unroll
        for (int i = 0; i < 4; ++i) {
            const int row = i * 8 + (lane >> 3), ch = lane & 7;
            const v4u v = *(const LAS v4u*)(stg + row * 64 + ch * 8);
            const size_t otok = (size_t)(b * SEQ + (i0 + 32 * w + row) * dil + cls);
            *(GAS v4u*)(OP + ((size_t)pat * NT + otok) * 512 + h * 64 + ch * 8) = v;
        }
        __syncthreads();
    }
}
__device__ __forceinline__ void p3_attn_merge(Frame& F) {
    const bf16* OP = wsp<bf16>(F, WS_OP); const float* LSE = wsp<float>(F, WS_LSE); bf16* MIX = wsp<bf16>(F, WS_MIX);
    const int gt = (F.vcu * NWAVES + F.wave) * 64 + F.lane, NGT = F.G * NWAVES * 64;
    for (int i = gt; i < NT * 64; i += NGT) {
        const int c = i & 7, h = (i >> 3) & 7, tok = i >> 6;
        const float l0 = LSE[((size_t)0 * NT + tok) * 8 + h], l1 = LSE[((size_t)1 * NT + tok) * 8 + h], l2 = LSE[((size_t)2 * NT + tok) * 8 + h];
        const float mm = fmaxf(fmaxf(l0, l1), l2);
        float w0 = exp2f(l0 - mm), w1 = exp2f(l1 - mm), w2 = exp2f(l2 - mm);
        const float inv = 1.0f / (w0 + w1 + w2); w0 *= inv; w1 *= inv; w2 *= inv;
        const size_t off = (size_t)tok * 512 + h * 64 + c * 8;
        const v4u a = *(const GAS v4u*)(OP + off), bq = *(const GAS v4u*)(OP + (size_t)NT * 512 + off), cq = *(const GAS v4u*)(OP + (size_t)2 * NT * 512 + off);
        v4u o;
        o.x = pk2(w0 * bflo(a.x) + w1 * bflo(bq.x) + w2 * bflo(cq.x), w0 * bfhi(a.x) + w1 * bfhi(bq.x) + w2 * bfhi(cq.x));
        o.y = pk2(w0 * bflo(a.y) + w1 * bflo(bq.y) + w2 * bflo(cq.y), w0 * bfhi(a.y) + w1 * bfhi(bq.y) + w2 * bfhi(cq.y));
        o.z = pk2(w0 * bflo(a.z) + w1 * bflo(bq.z) + w2 * bflo(cq.z), w0 * bfhi(a.z) + w1 * bfhi(bq.z) + w2 * bfhi(cq.z));
        o.w = pk2(w0 * bflo(a.w) + w1 * bflo(bq.w) + w2 * bflo(cq.w), w0 * bfhi(a.w) + w1 * bfhi(bq.w) + w2 * bfhi(cq.w));
        *(GAS v4u*)(MIX + (size_t)tok * 1024 + h * 64 + c * 8) = o;
    }
}
__device__ __forceinline__ float rg_conv_at(const bf16* U, const float (&cw)[4], float cb, int b, int tt, int ch) {
    float acc = cb;
#pragma unroll
    for (int k = 0; k < 4; ++k) { const int t2 = tt + k - 2; if (t2 >= 0 && t2 < SEQ) acc += cw[k] * bf2f(U[(size_t)(b * SEQ + t2) * 512 + ch]); }
    return acc;
}
__device__ __forceinline__ void rg_gate(float ucv, const float* aw, const float* xw, float ab, float xb, float sp, int lane, float& a, float& bb) {
    float pa = ab, px = xb;
#pragma unroll 16
    for (int i = 0; i < 64; ++i) { const float uu = __shfl(ucv, i); pa += uu * aw[i * 64 + lane]; px += uu * xw[i * 64 + lane]; }
    const float r = 1.f / (1.f + expf(-pa)), ig = 1.f / (1.f + expf(-px));
    const float la = -8.f * r * sp;
    a = expf(la);
    bb = sqrtf(-expm1f(2.f * la)) * (ig * ucv);
}
__device__ __forceinline__ void p2_rg1_simple(Frame& F) {
    const bf16* U = wsp<bf16>(F, WS_U); float* SUMM = wsp<float>(F, WS_SUMM);
    const int gw = F.vcu * NWAVES + F.wave, NGW = F.G * NWAVES, lane = F.lane;
    for (int u = gw; u < NB * 64 * 2 * 8; u += NGW) {
        const int g = u & 7, dir = (u >> 3) & 1, j = (u >> 4) & 63, b = u >> 10, ch = g * 64 + lane;
        float cw[4];
_Pragma("unroll") for (int k = 0; k < 4; ++k) cw[k] = F.conv_w[k * 512 + ch];
        const float cb = F.conv_b[ch], ab = F.a_b[dir * 512 + ch], xb = F.x_b[dir * 512 + ch], sp = log1pf(expf(-F.lam[dir * 512 + ch]));
        const float* aw = F.a_w + (size_t)(dir * 8 + g) * 4096; const float* xw = F.x_w + (size_t)(dir * 8 + g) * 4096;
        float A = 1.f, H = 0.f;
        for (int i = 0; i < 64; ++i) {
            const int tt = j * 64 + (dir == 0 ? i : 63 - i);
            const float ucv = rg_conv_at(U, cw, cb, b, tt, ch);
            float a, bb; rg_gate(ucv, aw, xw, ab, xb, sp, lane, a, bb);
            H = a * H + bb; A *= a;
        }
        float* o = SUMM + ((((size_t)b * 64 + j) * 2 + dir) * 512 + ch) * 2; o[0] = A; o[1] = H;
    }
}
__device__ __forceinline__ void p3_rg2_simple(Frame& F) {
    const bf16* U = wsp<bf16>(F, WS_U); const bf16* G = wsp<bf16>(F, WS_G); const float* SUMM = wsp<float>(F, WS_SUMM); float* HF = wsp<float>(F, WS_Q);     bf16* MIX = wsp<bf16>(F, WS_MIX);
    const int gw = F.vcu * NWAVES + F.wave, NGW = F.G * NWAVES, lane = F.lane;
    for (int u = gw; u < NB * 64 * 8; u += NGW) {
        const int g = u & 7, j = (u >> 3) & 63, b = u >> 9, ch = g * 64 + lane;
        float cw[4];
_Pragma("unroll") for (int k = 0; k < 4; ++k) cw[k] = F.conv_w[k * 512 + ch];
        const float cb = F.conv_b[ch];
#pragma unroll
        for (int dir = 0; dir < 2; ++dir) {
            const float ab = F.a_b[dir * 512 + ch], xb = F.x_b[dir * 512 + ch], sp = log1pf(expf(-F.lam[dir * 512 + ch]));
            const float* aw = F.a_w + (size_t)(dir * 8 + g) * 4096; const float* xw = F.x_w + (size_t)(dir * 8 + g) * 4096;
            float hc = 0.f;
            if (dir == 0) { for (int q = 0; q < j; ++q) { const float* s = SUMM + ((((size_t)b * 64 + q) * 2 + 0) * 512 + ch) * 2; hc = s[0] * hc + s[1]; } }
            else { for (int q = 63; q > j; --q) { const float* s = SUMM + ((((size_t)b * 64 + q) * 2 + 1) * 512 + ch) * 2; hc = s[0] * hc + s[1]; } }
            for (int i = 0; i < 64; ++i) {
                const int tt = j * 64 + (dir == 0 ? i : 63 - i);
                const float ucv = rg_conv_at(U, cw, cb, b, tt, ch);
                float a, bb; rg_gate(ucv, aw, xw, ab, xb, sp, lane, a, bb);
                hc = a * hc + bb;
                const size_t tok = (size_t)b * SEQ + tt;
                if (dir == 0) HF[tok * 512 + ch] = hc;
                else MIX[tok * 1024 + 512 + ch] = (bf16)f2bf((HF[tok * 512 + ch] + hc) * bf2f(G[tok * 512 + ch]));
            }
        }
    }
}

typedef float f32x4_t __attribute__((ext_vector_type(4)));
__device__ __forceinline__ float bf16_elem(const v4u& v, int e) { const unsigned w = (e >> 1) == 0 ? v.x : (e >> 1) == 1 ? v.y : (e >> 1) == 2 ? v.z : v.w; return (e & 1) ? bfhi(w) : bflo(w); }
template <int PASS> __device__ __forceinline__ void rg_wave(Frame& F, int lane, int b, int g, int j, LAS unsigned char* wl) {
    const int fr = lane & 15, fq = lane >> 4;
    const bf16* U = wsp<bf16>(F, WS_U); const bf16* RGW = wsp<bf16>(F, WS_RGW);
    {
        const int c = lane & 7, tg = lane >> 3, chb = 64 * g + 8 * c, t0 = j * 64 + 8 * tg;
        f32x4_t cw[4][2], cb[2];
#pragma unroll
        for (int k = 0; k < 4; ++k) { cw[k][0] = *(const GAS f32x4_t*)(F.conv_w + k * 512 + chb); cw[k][1] = *(const GAS f32x4_t*)(F.conv_w + k * 512 + chb + 4); }
        cb[0] = *(const GAS f32x4_t*)(F.conv_b + chb); cb[1] = *(const GAS f32x4_t*)(F.conv_b + chb + 4);
        v4u rows[11]; const bf16* Ub = U + (size_t)b * SEQ * 512;
#pragma unroll
        for (int i = 0; i < 11; ++i) { const int tt = t0 - 2 + i; const bool ok = tt >= 0 && tt < SEQ;
            rows[i] = ok ? *(const GAS v4u*)(Ub + ((ok ? tt : 0) * 512 + chb)) : (v4u){0u, 0u, 0u, 0u}; }
#pragma unroll
        for (int k = 0; k < 8; ++k) {
            float o[8];
#pragma unroll
            for (int e = 0; e < 8; ++e) { float acc = cb[e >> 2][e & 3];
#pragma unroll
                for (int d = 0; d < 4; ++d) acc += cw[d][e >> 2][e & 3] * bf16_elem(rows[k + d], e);
                o[e] = acc; }
            const v4u pk = {pk2(o[0], o[1]), pk2(o[2], o[3]), pk2(o[4], o[5]), pk2(o[6], o[7])};
            const int row = 8 * tg + k;
            *(LAS v4u*)(wl + row * 128 + ((c ^ ((row >> 1) & 7)) << 4)) = pk;
        }
    }
    if (PASS == 2) {
        const bf16* Gb = wsp<bf16>(F, WS_G) + ((size_t)b * SEQ + j * 64) * 512 + 64 * g;
#pragma unroll
        for (int k = 0; k < 8; ++k) { const int item = lane + 64 * k, row = item >> 3, c = item & 7;
            const v4u v = *(const GAS v4u*)(Gb + (row * 512 + 8 * c));
            *(LAS v4u*)(wl + 8192 + row * 128 + ((c ^ ((row >> 1) & 7)) << 4)) = v; }
    }
    LDS_WAIT();
    float c0 = 0.f, c1 = 0.f;
    if (PASS == 2) {
        const float2* S2 = (const float2*)wsp<float>(F, WS_SUMM);
        const int chm = 64 * g + 16 * fq + fr;
#pragma unroll 8
        for (int q = 0; q < j; ++q) { const float2 s = S2[((size_t)(b * 64 + q) * 2 + 0) * 512 + chm]; c0 = s.x * c0 + s.y; }
#pragma unroll 8
        for (int q = 63; q > j; --q) { const float2 s = S2[((size_t)(b * 64 + q) * 2 + 1) * 512 + chm]; c1 = s.x * c1 + s.y; }
    }
#pragma unroll 1
    for (int np = 0; np < 2; ++np) {
        float hf[4][2][4];
#pragma unroll
        for (int dir = 0; dir < 2; ++dir) {
            float ab[2], xb[2], c8[2], carry[2], At[2], Ht[2];
#pragma unroll
            for (int n = 0; n < 2; ++n) { const int ch = dir * 512 + 64 * g + 32 * np + 16 * n + fr; ab[n] = F.a_b[ch]; xb[n] = F.x_b[ch]; c8[n] = -8.f * 1.4426950408889634f * log1pf(expf(-F.lam[ch]));
                At[n] = 1.f; Ht[n] = 0.f; carry[n] = __shfl(dir == 0 ? c0 : c1, 16 * (2 * np + n) + fr); }
            bf16x8_t wf[2][2][2];
#pragma unroll
            for (int ty = 0; ty < 2; ++ty)
#pragma unroll
                for (int n = 0; n < 2; ++n)
#pragma unroll
                    for (int ks = 0; ks < 2; ++ks) wf[ty][n][ks] = *(const GAS bf16x8_t*)(RGW + ((size_t)((ty * 2 + dir) * 8 + g) * 64 + 32 * np + 16 * n + fr) * 64 + 32 * ks + 8 * fq);
#pragma unroll
            for (int mi = 0; mi < 4; ++mi) {
                const int m = dir == 0 ? mi : 3 - mi;
                bf16x8_t af[2];
#pragma unroll
                for (int ks = 0; ks < 2; ++ks) { const int row = 16 * m + fr; af[ks] = *(const LAS bf16x8_t*)(wl + row * 128 + (((fq + 4 * ks) ^ ((row >> 1) & 7)) << 4)); }
                f32x4_t acc[2][2];
#pragma unroll
                for (int ty = 0; ty < 2; ++ty)
#pragma unroll
                    for (int n = 0; n < 2; ++n) { f32x4_t a = {0.f, 0.f, 0.f, 0.f};
#pragma unroll
                        for (int ks = 0; ks < 2; ++ks) a = __builtin_amdgcn_mfma_f32_16x16x32_bf16(af[ks], wf[ty][n][ks], a, 0, 0, 0);
                        acc[ty][n] = a; }
#pragma unroll
                for (int n = 0; n < 2; ++n) {
                    const int chl = 32 * np + 16 * n + fr;
                    float av[4], bv[4];
#pragma unroll
                    for (int e = 0; e < 4; ++e) {
                        const int row = 16 * m + 4 * fq + e;
                        const float ucv = bf2f(*(const LAS unsigned short*)(wl + row * 128 + (((chl >> 3) ^ ((row >> 1) & 7)) << 4) + (chl & 7) * 2));
                        const float r = __builtin_amdgcn_rcpf(1.f + __builtin_amdgcn_exp2f(-1.4426950408889634f * (acc[0][n][e] + ab[n])));
                        const float ig = __builtin_amdgcn_rcpf(1.f + __builtin_amdgcn_exp2f(-1.4426950408889634f * (acc[1][n][e] + xb[n])));
                        const float la2 = c8[n] * r;
                        const float a = __builtin_amdgcn_exp2f(la2);
                        const float x2 = 2.f * 0.6931471805599453f * la2;
                        const float poly = x2 * (1.f + x2 * (0.5f + x2 * (0.16666667f + x2 * (0.041666668f + x2 * (0.0083333338f + x2 * 0.0013888889f)))));
                        const float em = x2 > -0.25f ? poly : a * a - 1.f;
                        av[e] = a; bv[e] = __builtin_amdgcn_sqrtf(-em) * (ig * ucv);
                    }
                    float Ai = 1.f, Hi = 0.f;
#pragma unroll
                    for (int ee = 0; ee < 4; ++ee) { const int e = dir == 0 ? ee : 3 - ee; Hi = av[e] * Hi + bv[e]; Ai *= av[e]; }
                    const int s1 = (dir == 0 ? lane - 16 : lane + 16) & 63, s2 = (dir == 0 ? lane - 32 : lane + 32) & 63;
                    const bool has1 = dir == 0 ? fq >= 1 : fq <= 2, has2 = dir == 0 ? fq >= 2 : fq <= 1;
                    { const float Ap = __shfl(Ai, s1), Hp = __shfl(Hi, s1); if (has1) { Hi = Ai * Hp + Hi; Ai = Ap * Ai; } }
                    { const float Ap = __shfl(Ai, s2), Hp = __shfl(Hi, s2); if (has2) { Hi = Ai * Hp + Hi; Ai = Ap * Ai; } }
                    const int lt = dir == 0 ? 48 + fr : fr;
                    const float Atot = __shfl(Ai, lt), Htot = __shfl(Hi, lt);
                    if (PASS == 1) { Ht[n] = Atot * Ht[n] + Htot; At[n] *= Atot; }
                    else {
                        float Aex = __shfl(Ai, s1), Hex = __shfl(Hi, s1);
                        if (!has1) { Aex = 1.f; Hex = 0.f; }
                        float h = Aex * carry[n] + Hex;
#pragma unroll
                        for (int ee = 0; ee < 4; ++ee) { const int e = dir == 0 ? ee : 3 - ee; h = av[e] * h + bv[e];
                            if (dir == 0) hf[m][n][e] = h;
                            else {
                                const int row = 16 * m + 4 * fq + e;
                                LAS unsigned short* gp = (LAS unsigned short*)(wl + 8192 + row * 128 + (((chl >> 3) ^ ((row >> 1) & 7)) << 4) + (chl & 7) * 2);
                                *gp = (unsigned short)f2bf((hf[m][n][e] + h) * bf2f(*gp));
                            } }
                        carry[n] = Atot * carry[n] + Htot;
                    }
                }
            }
            if (PASS == 1 && fq == 0) {
                float2* S2 = (float2*)wsp<float>(F, WS_SUMM);
#pragma unroll
                for (int n = 0; n < 2; ++n) S2[((size_t)(b * 64 + j) * 2 + dir) * 512 + 64 * g + 32 * np + 16 * n + fr] = make_float2(At[n], Ht[n]);
            }
        }
    }
    if (PASS == 2) {
        LDS_WAIT();
        bf16* Mb = wsp<bf16>(F, WS_MIX) + ((size_t)b * SEQ + j * 64) * 1024 + 512 + 64 * g;
        int l2 = lane; asm volatile("" : "+v"(l2));
#pragma unroll
        for (int k = 0; k < 8; ++k) { const int item = l2 + 64 * k, row = item >> 3, c = item & 7;
            const v4u v = *(const LAS v4u*)(wl + 8192 + row * 128 + ((c ^ ((row >> 1) & 7)) << 4));
            *(GAS v4u*)(Mb + (row * 1024 + 8 * c)) = v; }
    }
}
template <int PASS> __device__ __forceinline__ void rg_phase(Frame& F) {
    const int gw = F.vcu * NWAVES + F.wave, NGW = F.G * NWAVES;
    LAS unsigned char* wl = F.lds + F.wave * 16384;
    for (int u = gw; u < NB * 8 * 64; u += NGW) { int lane = F.lane; asm volatile("" : "+v"(lane));
        rg_wave<PASS>(F, lane, u >> 9, (u >> 6) & 7, u & 63, wl); LDS_WAIT(); }
}
__device__ __forceinline__ void p9_final(Frame& F, float* dst) {
    const int gw = F.vcu * NWAVES + F.wave, NGW = F.G * NWAVES, lane = F.lane;
    for (int m = gw; m < NT; m += NGW) {
        GAS f32x4* p = (GAS f32x4*)(F.out + (size_t)m * DM) + lane; GAS f32x4* q = (GAS f32x4*)(dst + (size_t)m * DM) + lane;
        f32x4 v[4]; float s = 0.f;
#pragma unroll
        for (int j = 0; j < 4; ++j) { v[j] = p[64 * j]; s += (v[j].x * v[j].x + v[j].y * v[j].y) + (v[j].z * v[j].z + v[j].w * v[j].w); }
        s = wave_sum(s);
        const float r = 1.0f / sqrtf(s * (1.f / DM) + NORM_EPS);
#pragma unroll
        for (int j = 0; j < 4; ++j) { const f32x4 gg = ((const GAS f32x4*)F.g_fin)[lane + 64 * j]; q[64 * j] = v[j] * r * gg; }
    }
}

struct Args { const void* in[23]; float* out; unsigned char* ws; int ph_lo, ph_hi; };
static_assert(sizeof(Args) == 23 * 8 + 8 + 8 + 8, "Args has no padding");

__global__ void __launch_bounds__(NWAVES * 64, 2) mk_fwd(Args args) {
    extern __shared__ __attribute__((aligned(16))) unsigned char lds[];
    Frame F;
    F.lds = (LAS unsigned char*)lds;
    F.MISC = (volatile LAS unsigned*)(F.lds + MISC_OFF);
    F.wave = __builtin_amdgcn_readfirstlane((int)threadIdx.x >> 6);
    F.lane = (int)__builtin_amdgcn_mbcnt_hi(~0u, __builtin_amdgcn_mbcnt_lo(~0u, 0u)); F.tid = F.wave * 64 + F.lane;
    F.G = gridDim.x; { const int bx = blockIdx.x; F.vcu = (F.G % 8 == 0) ? (bx % 8) * (F.G / 8) + bx / 8 : bx; }
    F.ws = args.ws; F.ctl = (gu32*)(args.ws + WS_CTL);
    F.x = (const float*)args.in[0]; F.mem = (const float*)args.in[1]; F.pos = (const int*)args.in[2]; F.out = args.out;
    F.g_mix = (const float*)args.in[3]; F.w_in = (const float*)args.in[4]; F.conv_w = (const float*)args.in[5]; F.conv_b = (const float*)args.in[6];
    F.a_w = (const float*)args.in[7]; F.a_b = (const float*)args.in[8]; F.x_w = (const float*)args.in[9]; F.x_b = (const float*)args.in[10]; F.lam = (const float*)args.in[11];
    F.w_out = (const float*)args.in[12]; F.g_cross = (const float*)args.in[13]; F.g_mem = (const float*)args.in[14]; F.w_cq = (const float*)args.in[15]; F.w_ck = (const float*)args.in[16];
    F.w_cv = (const float*)args.in[17]; F.w_co = (const float*)args.in[18]; F.g_mlp = (const float*)args.in[19]; F.w_mi = (const float*)args.in[20]; F.w_mo = (const float*)args.in[21]; F.g_fin = (const float*)args.in[22];
    for (int u = F.tid; u < (LDS_BYTES - LDSCTL_OFF) / 4; u += NWAVES * 64) ((LAS unsigned*)(F.lds + LDSCTL_OFF))[u] = 0u;
    __syncthreads();
    XcdBarrier bar; bar.bar = (unsigned*)(F.ctl + CW_BAR); bar.x = 0; bar.st = nullptr;
    if (N_LAUNCHES == 1) bar = xcd_barrier_post((unsigned*)(F.ctl + CW_BAR), F.MISC + 8, F.tid == 0);
#ifndef PROBE_BARS
#define PROBE_BARS 1
#endif
#define GRID_BAR() do { if (N_LAUNCHES == 1) { for (int nb_ = 0; nb_ < PROBE_BARS; ++nb_) xcd_barrier(bar, F.wave == 0 && F.lane == 0); } } while (0)
    const int lo = args.ph_lo, hi = args.ph_hi;
#ifndef PROBE_DUP
#define PROBE_DUP -1
#endif
#define REP(k) for (int rep_##k = 0; rep_##k < ((k) == PROBE_DUP ? 2 : 1) && ({ asm volatile("" : "+v"(F.lane)); true; }); ++rep_##k)
#define IN(k) (lo <= (k) && (k) < hi)
#define BOTH(k) (IN(k) && IN((k) + 1))
    using namespace pg8;
    bf16_t* XB = wsp<bf16_t>(F, WS_XB); bf16_t* MIXB = wsp<bf16_t>(F, WS_MIX);
    float* SSQ1 = wsp<float>(F, WS_SSQ1); float* SSQ2 = wsp<float>(F, WS_SSQ2);

    if (IN(0)) { REP(0) p0_prologue(F); if (BOTH(0)) GRID_BAR(); }
    if (IN(1)) {
        Gemm g{XB, wsp<bf16_t>(F, WS_WIN), DM, DM, DM, 30, 0};
        OrderP1 S; S.base.init(NT, 2560, F.G, (int)blockIdx.x);
        EpiProj E{wsp<bf16_t>(F, WS_Q), wsp<bf16_t>(F, WS_K), wsp<bf16_t>(F, WS_V), wsp<bf16_t>(F, WS_U), wsp<bf16_t>(F, WS_G), wsp<bf16_t>(F, WS_KVM), wsp<float>(F, WS_RS0), wsp<float>(F, WS_RSM), wsp<float>(F, WS_TAB)};
        REP(1) gemm_phase<EpiProj, OrderP1, true, true>(F.lds + RING_OFF, g, S, E, F.wave);
        if (BOTH(1)) GRID_BAR();
    }
    if (IN(2)) { REP(2) { REP(20) p2_attn_mfma(F); REP(21) p2_cross_weights(F); REP(22) rg_phase<1>(F); } if (BOTH(2)) GRID_BAR(); }
    if (IN(3)) { REP(3) { REP(30) p3_attn_merge(F); REP(31) rg_phase<2>(F); } if (BOTH(3)) GRID_BAR(); }
    if (IN(4)) {
        Gemm g{MIXB, wsp<bf16_t>(F, WS_WOUT), DM, DM, DM, 30, 0};
        StaticOrder S; S.init(NT, DM, F.G, (int)blockIdx.x);
        EpiRes E{F.x, F.out, XB, SSQ1};
        REP(4) gemm_phase<EpiRes, StaticOrder, false, true>(F.lds + RING_OFF, g, S, E, F.wave);
        if (BOTH(4)) GRID_BAR();
    }
    if (IN(5)) {
        Gemm g{XB, wsp<bf16_t>(F, WS_BTS), DM, DM, DM, 4, (size_t)1024 * 1024 * 2};
        StaticOrder S; S.init(NT, DM, F.G, (int)blockIdx.x);
        EpiSoftmax E{SSQ1, MIXB};
        REP(5) gemm_phase<EpiSoftmax, StaticOrder, false, true>(F.lds + RING_OFF, g, S, E, F.wave);
        if (BOTH(5)) GRID_BAR();
    }
    if (IN(6)) {
        Gemm g{MIXB, wsp<bf16_t>(F, WS_BTO), DM, DM, DM, 4, (size_t)1024 * 1024 * 2};
        StaticOrder S; S.init(NT, DM, F.G, (int)blockIdx.x);
        EpiRes E{F.out, F.out, XB, SSQ2};
        if (PROBE_DUP == 6) { EpiRes E0{F.out, wsp<float>(F, WS_HID), wsp<bf16_t>(F, WS_HID + 64 * MiB), SSQ2}; gemm_phase<EpiRes, StaticOrder, false, true>(F.lds + RING_OFF, g, S, E0, F.wave); }
        gemm_phase<EpiRes, StaticOrder, false, true>(F.lds + RING_OFF, g, S, E, F.wave);
        if (BOTH(6)) GRID_BAR();
    }
    if (IN(7)) {
        Gemm g{XB, wsp<bf16_t>(F, WS_WMI), DM, DM, DM, 30, 0};
        StaticOrder S; S.init(NT, FF, F.G, (int)blockIdx.x);
        EpiMlpIn E{SSQ2, wsp<bf16_t>(F, WS_HID)};
        REP(7) gemm_phase<EpiMlpIn, StaticOrder, true, true>(F.lds + RING_OFF, g, S, E, F.wave);
        if (BOTH(7)) GRID_BAR();
    }
    if (IN(8)) {
        Gemm g{wsp<bf16_t>(F, WS_HID), wsp<bf16_t>(F, WS_WMO), FF, FF, FF, 30, 0};
        StaticOrder S; S.init(NT, DM, F.G, (int)blockIdx.x);
        EpiRes E{F.out, F.out, nullptr, nullptr};
        if (PROBE_DUP == 8) { EpiRes E0{F.out, wsp<float>(F, WS_XB), nullptr, nullptr}; gemm_phase<EpiRes, StaticOrder, false, true>(F.lds + RING_OFF, g, S, E0, F.wave); }
        gemm_phase<EpiRes, StaticOrder, false, true>(F.lds + RING_OFF, g, S, E, F.wave);
        if (BOTH(8)) GRID_BAR();
    }
    if (IN(9)) { if (PROBE_DUP == 9) p9_final(F, wsp<float>(F, WS_XB)); p9_final(F, F.out); }
#undef IN
#undef BOTH
}

extern "C" void kernel_launch(void* const* d_in, const int* in_sizes, int n_in, void* d_out, int out_size, void* d_ws, size_t ws_size, hipStream_t stream) {
    static int grid = 0;
    if (grid == 0) {
        if (n_in != 23 || in_sizes[0] != NT * DM || out_size != NT * DM || ws_size < WS_END) { fprintf(stderr, "kernel_launch: unexpected shapes (n_in %d, in0 %d, out %d, ws %zu); nothing launched\n", n_in, n_in > 0 ? in_sizes[0] : -1, out_size, ws_size); grid = -1; return; }
        int dev = 0, cus = 0, per_cu = 0;
        if (hipGetDevice(&dev) != hipSuccess || hipDeviceGetAttribute(&cus, hipDeviceAttributeMultiprocessorCount, dev) != hipSuccess) { grid = -1; return; }
        if (hipFuncSetAttribute((const void*)mk_fwd, hipFuncAttributeMaxDynamicSharedMemorySize, LDS_BYTES) != hipSuccess) { fprintf(stderr, "kernel_launch: hipFuncSetAttribute failed\n"); grid = -1; return; }
        if (hipOccupancyMaxActiveBlocksPerMultiprocessor(&per_cu, (const void*)mk_fwd, NWAVES * 64, LDS_BYTES) != hipSuccess || per_cu < 1) { fprintf(stderr, "kernel_launch: occupancy query says %d workgroups per CU\n", per_cu); }
        (void)hipGetLastError();
        grid = cus;
        if (grid != 256) { fprintf(stderr, "kernel_launch: built for a 256-CU device, found %d CUs; nothing launched\n", grid); grid = -1; return; }
    }
    if (grid < 0) return;
    if (hipMemsetAsync((char*)d_ws + WS_CTL, 0, CTL_ZERO_BYTES, stream) != hipSuccess) { fprintf(stderr, "kernel_launch: hipMemsetAsync failed\n"); return; }
    Args a{};
    for (int i = 0; i < 23; ++i) a.in[i] = d_in[i];
    a.out = (float*)d_out; a.ws = (unsigned char*)d_ws;
    if (N_LAUNCHES == 1) {
        a.ph_lo = 0; a.ph_hi = N_PHASES;
        void* kargs[] = {&a};
        const hipError_t le = hipLaunchCooperativeKernel((const void*)mk_fwd, dim3(grid), dim3(NWAVES * 64), kargs, LDS_BYTES, stream);
        if (le != hipSuccess) fprintf(stderr, "kernel_launch: cooperative launch failed: %s\n", hipGetErrorName(le));
    } else {
        for (int li = 0; li < N_PHASES; ++li) {
            a.ph_lo = li; a.ph_hi = li + 1;
            hipLaunchKernelGGL(mk_fwd, dim3(grid), dim3(NWAVES * 64), LDS_BYTES, stream, a);
        }
    }
}
```

```cpp
#include <hip/hip_runtime.h>
#include <cstdio>
#include <cstdint>
#include <cmath>

constexpr int NB = 4, SEQ = 4096, DM = 1024, NT = NB * SEQ, FF = 4096, NMEM = 256;
constexpr float NORM_EPS = 1e-6f;
constexpr float QSCALE = 0.125f * 1.4426950408889634f;
constexpr float CSCALE = 0.08838834764831845f * 1.4426950408889634f;

namespace pg8 {
#define PG8_LAS __attribute__((address_space(3)))
typedef unsigned short bf16_t;
typedef short bf16x8 __attribute__((ext_vector_type(8)));
typedef float f32x4 __attribute__((ext_vector_type(4)));
typedef float f32x2 __attribute__((ext_vector_type(2)));
typedef unsigned u32x4 __attribute__((ext_vector_type(4)));
typedef unsigned u32x2 __attribute__((ext_vector_type(2)));
constexpr int BM = 256, BK = 64, HALF = 128, HTB = HALF * BK * 2  , STAGE_BYTES = 8 * HTB, NXCD = 8, WGM = 8;

__host__ __device__ __forceinline__ int lds_byte(int r, int c) { const int st = (r >> 4) * 2 + (c >> 5), rr = r & 15, cc = c & 31, ob = rr * 64 + cc * 2; return st * 1024 + (ob ^ (((ob >> 9) & 1) << 5)); }
__host__ __device__ __forceinline__ void stage_rc(int b, int& R, int& C) { const int st = b / 1024, sb = b % 1024, swz = sb ^ (((sb >> 9) & 1) << 5); R = (st >> 1) * 16 + swz / 64; C = (st & 1) * 32 + (swz % 64) / 2; }
__host__ __device__ __forceinline__ int perm32(int rho) { const int n = rho >> 4, i = rho & 15; return 8 * (i >> 2) + 4 * n + (i & 3); }
__host__ __device__ __forceinline__ int perm_id(int R) { return R; }
__host__ __device__ __forceinline__ int perm_std(int R) { return (R & ~31) + perm32(R & 31); }
__host__ __device__ __forceinline__ int perm_rope(int R) { const int wc = R >> 5, rho = R & 31, n = rho >> 4, i = rho & 15; return 64 * (wc >> 1) + 32 * n + 16 * (wc & 1) + i; }

struct Unit { int pm, pn; };
struct Gemm { const bf16_t* A; const bf16_t* Bt; int K, lda, ldb, bshift; size_t bstride; };

struct StaticOrder {
    int nM, nN, nwg, G, c;
    __host__ __device__ void init(int M, int N, int G_, int c_) { nM = M / BM; nN = N / BM; nwg = nM * nN; G = G_; c = c_; }
    __host__ __device__ bool next(int i, Unit& u) const {
        const long L = (long)i * G + c; if (L >= nwg) return false;
        int wgid = (int)L; { const int q = nwg / NXCD, r = nwg % NXCD, xcd = wgid % NXCD, off = wgid / NXCD; wgid = (xcd < r ? xcd * (q + 1) : r * (q + 1) + (xcd - r) * q) + off; }
        const int nig = WGM * nN, gid = wgid / nig, fm = gid * WGM, gsz = (nM - fm) < WGM ? (nM - fm) : WGM;
        u.pm = fm + ((wgid % nig) % gsz); u.pn = (wgid % nig) / gsz; return true;
    }
    __device__ __forceinline__ void a_ready(const Unit&) const {}
    __device__ __forceinline__ void done(const Unit&) const {}
};
struct OrderP1 {
    StaticOrder base;
    __device__ bool next(int i, Unit& u) const {
        if (base.next(i, u)) return true;
        const long e = (long)i * base.G + base.c - base.nwg; if (e >= 16) return false;
        u.pm = 64 + (int)(e >> 2); u.pn = 10 + (int)(e & 3); return true;
    }
    __device__ __forceinline__ void a_ready(const Unit&) const {}
    __device__ __forceinline__ void done(const Unit&) const {}
};

__device__ __forceinline__ unsigned cvt_pk_bf16(float lo, float hi) { unsigned r; asm volatile("v_cvt_pk_bf16_f32 %0, %1, %2" : "=v"(r) : "v"(lo), "v"(hi)); return r; }
__device__ __forceinline__ float gelu_tanh_f(float x) {
    const float z2 = -2.0f * 1.4426950408889634f * 0.7978845608028654f * (x + 0.044715f * x * x * x);
    return x * __builtin_amdgcn_rcpf(1.0f + __builtin_amdgcn_exp2f(z2));
}
__device__ __forceinline__ float rstd_from_ssq16(const float* p) {
    const f32x4 a = *(const f32x4*)p, b = *(const f32x4*)(p + 4), c = *(const f32x4*)(p + 8), d = *(const f32x4*)(p + 12);
    const float s = ((a[0] + a[1]) + (a[2] + a[3])) + ((b[0] + b[1]) + (b[2] + b[3])) + ((c[0] + c[1]) + (c[2] + c[3])) + ((d[0] + d[1]) + (d[2] + d[3]));
    return 1.0f / sqrtf(s * (1.0f / 1024.0f) + NORM_EPS);
}


struct EpiProj {
    static constexpr bool AFTER_DRAIN = false;
    __host__ __device__ static __forceinline__ int perm_row(int R) { return perm_rope(R); }
    bf16_t *Q, *K, *V, *U, *G, *KVM; const float* rs0; const float* rsm; const float* tab;
    __device__ __forceinline__ void operator()(const f32x4 (&acc)[2][2][4][2], const Unit& u, int wr, int wc, int fr, int fq) const {
        const bool is_mem = u.pm >= 64;
        const int typ = is_mem ? 5 : (u.pn >> 1);
        const int colh = 64 * (wc >> 1) + 16 * (wc & 1) + 4 * fq;
        bf16_t* T; int pitch, col0; const float* rs; int rsub;
        if (is_mem) { T = KVM; pitch = 1024; col0 = (u.pn - 10) * 256 + colh; rs = rsm; rsub = 64 * 256; }
        else { T = typ == 0 ? Q : typ == 1 ? K : typ == 2 ? V : typ == 3 ? U : G; pitch = 512; col0 = (u.pn & 1) * 256 + colh; rs = rs0; rsub = 0; }
#pragma unroll
        for (int ai = 0; ai < 2; ++ai)
#pragma unroll
            for (int m = 0; m < 4; ++m) {
                const int row = u.pm * BM + ai * HALF + wr * 64 + m * 16 + fr - rsub;
                const float sc = rs[row];
                bf16_t* rowp = T + (size_t)row * pitch + col0;
                f32x4 cs0 = {1.f, 0.f, 1.f, 0.f}, cs1 = {1.f, 0.f, 1.f, 0.f};
                if (typ <= 1) { const f32x4* tp = (const f32x4*)(tab + (size_t)row * 64 + 2 * (16 * (wc & 1) + 4 * fq)); cs0 = tp[0]; cs1 = tp[1]; }
#pragma unroll
                for (int bj = 0; bj < 2; ++bj) {
                    f32x4 v0 = acc[ai][bj][m][0] * sc, v1 = acc[ai][bj][m][1] * sc;
                    if (typ <= 1) {
                        const f32x4 c = {cs0[0], cs0[2], cs1[0], cs1[2]}, s = {cs0[1], cs0[3], cs1[1], cs1[3]};
                        const f32x4 lo = v0 * c - v1 * s, hi = v0 * s + v1 * c;
                        v0 = lo; v1 = hi;
                        if (typ == 0) { v0 = v0 * QSCALE; v1 = v1 * QSCALE; }
                    } else if (typ == 4) {
#pragma unroll
                        for (int e = 0; e < 4; ++e) { v0[e] = gelu_tanh_f(v0[e]); v1[e] = gelu_tanh_f(v1[e]); }
                    }
                    u32x2 w0, w1; w0.x = cvt_pk_bf16(v0[0], v0[1]); w0.y = cvt_pk_bf16(v0[2], v0[3]); w1.x = cvt_pk_bf16(v1[0], v1[1]); w1.y = cvt_pk_bf16(v1[2], v1[3]);
                    *(u32x2*)(rowp + bj * HALF) = w0; *(u32x2*)(rowp + bj * HALF + 32) = w1;
                }
            }
    }
};

struct EpiRes {
    static constexpr bool AFTER_DRAIN = false;
    __host__ __device__ static __forceinline__ int perm_row(int R) { return perm_id(R); }
    const float* base; float* out; bf16_t* outb; float* ssq;
    __device__ __forceinline__ void operator()(const f32x4 (&acc)[2][2][4][2], const Unit& u, int wr, int wc, int fr, int fq) const {
#pragma unroll
        for (int ai = 0; ai < 2; ++ai)
#pragma unroll
            for (int m = 0; m < 4; ++m) {
                const int row = u.pm * BM + ai * HALF + wr * 64 + m * 16 + fr;
                const size_t off = (size_t)row * 1024 + u.pn * BM + wc * 32 + 4 * fq;
                float q = 0.f;
#pragma unroll
                for (int bj = 0; bj < 2; ++bj)
#pragma unroll
                    for (int n = 0; n < 2; ++n) {
                        const f32x4 bs = *(const f32x4*)(base + off + bj * HALF + n * 16);
                        const f32x4 o = bs + acc[ai][bj][m][n];
                        *(f32x4*)(out + off + bj * HALF + n * 16) = o;
                        q += (o[0] * o[0] + o[1] * o[1]) + (o[2] * o[2] + o[3] * o[3]);
                        if (outb) { u32x2 w; w.x = cvt_pk_bf16(o[0], o[1]); w.y = cvt_pk_bf16(o[2], o[3]); *(u32x2*)(outb + off + bj * HALF + n * 16) = w; }
                    }
                q += __shfl_xor(q, 16); q += __shfl_xor(q, 32);
                if (ssq && fq == 0) ssq[(size_t)row * 16 + u.pn * 4 + wc] = q;
                if (m & 1) asm volatile("" ::: "memory");
            }
    }
};

struct EpiSoftmax {
    static constexpr bool AFTER_DRAIN = true;
    __host__ __device__ static __forceinline__ int perm_row(int R) { return perm_std(R); }
    const float* ssq; bf16_t* P;
    __device__ __forceinline__ void fused(f32x4 (&acc)[2][2][4][2], const Unit& u, int wr, int wc, int fr, int fq, PG8_LAS unsigned char* lds, int wid, int lane) const {
        PG8_LAS float* PM = (PG8_LAS float*)lds;
        PG8_LAS float* PS = (PG8_LAS float*)(lds + 4096);
#pragma unroll
        for (int ai = 0; ai < 2; ++ai)
#pragma unroll
            for (int m = 0; m < 4; ++m) {
                const int rt = ai * HALF + wr * 64 + m * 16 + fr;
                const float sc = rstd_from_ssq16(ssq + (size_t)(u.pm * BM + rt) * 16);
                float mx = -3.0e38f;
#pragma unroll
                for (int bj = 0; bj < 2; ++bj)
#pragma unroll
                    for (int n = 0; n < 2; ++n) { f32x4 v = acc[ai][bj][m][n] * sc; acc[ai][bj][m][n] = v; mx = fmaxf(mx, fmaxf(fmaxf(v[0], v[1]), fmaxf(v[2], v[3]))); }
                mx = fmaxf(mx, __shfl_xor(mx, 16)); mx = fmaxf(mx, __shfl_xor(mx, 32));
                if (fq == 0) PM[rt * 4 + wc] = mx;
            }
        asm volatile("s_waitcnt lgkmcnt(0)" ::: "memory"); __builtin_amdgcn_s_barrier(); asm volatile("" ::: "memory");
#pragma unroll
        for (int ai = 0; ai < 2; ++ai)
#pragma unroll
            for (int m = 0; m < 4; ++m) {
                const int rt = ai * HALF + wr * 64 + m * 16 + fr;
                const f32x4 pm4 = *(const PG8_LAS f32x4*)(PM + rt * 4);
                const float mx = fmaxf(fmaxf(pm4[0], pm4[1]), fmaxf(pm4[2], pm4[3]));
                float s = 0.f;
#pragma unroll
                for (int bj = 0; bj < 2; ++bj)
#pragma unroll
                    for (int n = 0; n < 2; ++n) { f32x4 v = acc[ai][bj][m][n];
#pragma unroll
                        for (int e = 0; e < 4; ++e) v[e] = __builtin_amdgcn_exp2f(v[e] - mx);
                        acc[ai][bj][m][n] = v; s += (v[0] + v[1]) + (v[2] + v[3]); }
                s += __shfl_xor(s, 16); s += __shfl_xor(s, 32);
                if (fq == 0) PS[rt * 4 + wc] = s;
            }
        asm volatile("s_waitcnt lgkmcnt(0)" ::: "memory"); __builtin_amdgcn_s_barrier(); asm volatile("" ::: "memory");
#pragma unroll
        for (int ai = 0; ai < 2; ++ai)
#pragma unroll
            for (int m = 0; m < 4; ++m) {
                const int rt = ai * HALF + wr * 64 + m * 16 + fr;
                const f32x4 ps4 = *(const PG8_LAS f32x4*)(PS + rt * 4);
                const float inv = 1.0f / ((ps4[0] + ps4[1]) + (ps4[2] + ps4[3]));
                bf16_t* rowp = P + (size_t)(u.pm * BM + rt) * 1024 + u.pn * BM + wc * 32 + 8 * fq;
#pragma unroll
                for (int bj = 0; bj < 2; ++bj) { const f32x4 v0 = acc[ai][bj][m][0] * inv, v1 = acc[ai][bj][m][1] * inv;
                    u32x4 w; w.x = cvt_pk_bf16(v0[0], v0[1]); w.y = cvt_pk_bf16(v0[2], v0[3]); w.z = cvt_pk_bf16(v1[0], v1[1]); w.w = cvt_pk_bf16(v1[2], v1[3]);
                    *(u32x4*)(rowp + bj * HALF) = w; }
            }
    }
};

struct EpiMlpIn {
    static constexpr bool AFTER_DRAIN = false;
    __host__ __device__ static __forceinline__ int perm_row(int R) { return perm_std(R); }
    const float* ssq; bf16_t* H;
    __device__ __forceinline__ void operator()(const f32x4 (&acc)[2][2][4][2], const Unit& u, int wr, int wc, int fr, int fq) const {
#pragma unroll
        for (int ai = 0; ai < 2; ++ai)
#pragma unroll
            for (int m = 0; m < 4; ++m) {
                const int row = u.pm * BM + ai * HALF + wr * 64 + m * 16 + fr;
                const float sc = rstd_from_ssq16(ssq + (size_t)row * 16);
                bf16_t* rowp = H + (size_t)row * 4096 + u.pn * BM + wc * 32 + 8 * fq;
#pragma unroll
                for (int bj = 0; bj < 2; ++bj) {
                    f32x4 v0 = acc[ai][bj][m][0] * sc, v1 = acc[ai][bj][m][1] * sc;
#pragma unroll
                    for (int e = 0; e < 4; ++e) { const float a = fmaxf(v0[e], 0.f), b = fmaxf(v1[e], 0.f); v0[e] = a * a; v1[e] = b * b; }
                    u32x4 w; w.x = cvt_pk_bf16(v0[0], v0[1]); w.y = cvt_pk_bf16(v0[2], v0[3]); w.z = cvt_pk_bf16(v1[0], v1[1]); w.w = cvt_pk_bf16(v1[2], v1[3]);
                    *(u32x4*)(rowp + bj * HALF) = w;
                }
            }
    }
};

template <class Epi, class Sched, bool ALIGN_EPI = false, bool SP2 = false>
__device__ __forceinline__ void gemm_phase(PG8_LAS unsigned char* lds, const Gemm g, const Sched& S, const Epi& E, int wid_) {
    const int wid = wid_, lane = (int)__builtin_amdgcn_mbcnt_hi(~0u, __builtin_amdgcn_mbcnt_lo(~0u, 0u)), tid = wid * 64 + lane, wr = wid >> 2, wc = wid & 3, fr = lane & 15, fq = lane >> 4;
    const int K = g.K, nt = K / BK;
    unsigned voffA[2], voffB[2];
#pragma unroll
    for (int i = 0; i < 2; ++i) { int R, C; stage_rc(tid * 16 + i * 8192, R, C); const int Rb = Epi::perm_row(R);
        voffA[i] = (unsigned)(R * g.lda + C) * 2u; voffB[i] = (unsigned)(Rb * g.ldb + C) * 2u; }
    const size_t kstep = (size_t)(BK * 2);
    const size_t hstepA = (size_t)HALF * g.lda * 2, hstepB = (size_t)HALF * g.ldb * 2;
    const size_t tstepA = 2 * hstepA, tstepB = 2 * hstepB;
#define PG8_BASEA(u) ((const char*)g.A + (size_t)(u).pm * tstepA)
#define PG8_BASEB(u) ((const char*)g.Bt + (size_t)((u).pm >> g.bshift) * g.bstride + (size_t)(u).pn * tstepB)
    const unsigned ldsw = (unsigned)wid * 1024u;
    const int aoff = lds_byte(wr * 64 + fr, fq * 8), boff = lds_byte(wc * 32 + fr, fq * 8);
#define PG8_SA(b, h) (((b) * 2 + (h)) * HTB)
#define PG8_SB(b, h) ((4 + (b) * 2 + (h)) * HTB)
#define PG8_STAGE(bufoff, gbase, voff) do { _Pragma("unroll") for (int _i = 0; _i < 2; ++_i) \
        __builtin_amdgcn_global_load_lds((const unsigned*)((const char*)(gbase) + (voff)[_i]), (PG8_LAS unsigned*)(lds + (bufoff) + ldsw + _i * 8192), 16, 0, 0); } while (0)
#define PG8_LDA(dst, b, h) do { _Pragma("unroll") for (int m = 0; m < 4; ++m) _Pragma("unroll") for (int k = 0; k < 2; ++k) dst[m][k] = *(const PG8_LAS bf16x8*)(lds + PG8_SA(b, h) + aoff + m * 2048 + k * 1024); } while (0)
#define PG8_LDB(dst, b, h) do { _Pragma("unroll") for (int n = 0; n < 2; ++n) _Pragma("unroll") for (int k = 0; k < 2; ++k) dst[n][k] = *(const PG8_LAS bf16x8*)(lds + PG8_SB(b, h) + boff + n * 2048 + k * 1024); } while (0)
#define PG8_MMA(ai, bj, At, Bt) do { __builtin_amdgcn_s_setprio(1); _Pragma("unroll") for (int m = 0; m < 4; ++m) _Pragma("unroll") for (int n = 0; n < 2; ++n) _Pragma("unroll") for (int k = 0; k < 2; ++k) \
        acc[ai][bj][m][n] = __builtin_amdgcn_mfma_f32_16x16x32_bf16(Bt[n][k], At[m][k], acc[ai][bj][m][n], 0, 0, 0); __builtin_amdgcn_s_setprio(0); } while (0)
#define PG8_WAIT_V(n) asm volatile("s_waitcnt vmcnt(" #n ")" ::: "memory")
#define PG8_WAIT_L(n) asm volatile("s_waitcnt lgkmcnt(" #n ")" ::: "memory")
#define PG8_BAR __builtin_amdgcn_s_barrier()
#define PG8_SCHED __builtin_amdgcn_sched_barrier(0)
    Unit cur, nxt; int ui = 0;
    if (!S.next(0, cur)) return;
    f32x4 acc[2][2][4][2];
#pragma unroll
    for (int a = 0; a < 2; ++a)
#pragma unroll
        for (int b = 0; b < 2; ++b)
#pragma unroll
            for (int m = 0; m < 4; ++m)
#pragma unroll
                for (int n = 0; n < 2; ++n) acc[a][b][m][n] = (f32x4){0.f, 0.f, 0.f, 0.f};
    bf16x8 At[4][2], B0[2][2], B1[2][2];
    const char* cA = PG8_BASEA(cur); const char* cB = PG8_BASEB(cur);
    S.a_ready(cur);
    if constexpr (SP2) {
        PG8_STAGE(PG8_SB(0, 0), cB, voffB); PG8_STAGE(PG8_SB(0, 1), cB + hstepB, voffB); PG8_STAGE(PG8_SA(0, 0), cA, voffA); PG8_STAGE(PG8_SA(0, 1), cA + hstepA, voffA);
        if (wr == 1) PG8_BAR;
        PG8_WAIT_V(2); PG8_BAR;
        PG8_STAGE(PG8_SB(1, 0), cB + kstep, voffB); PG8_STAGE(PG8_SA(1, 0), cA + kstep, voffA); PG8_STAGE(PG8_SB(1, 1), cB + hstepB + kstep, voffB);
        PG8_WAIT_V(6); PG8_BAR;
    } else {
        PG8_STAGE(PG8_SB(0, 0), cB, voffB); PG8_STAGE(PG8_SA(0, 0), cA, voffA); PG8_STAGE(PG8_SB(0, 1), cB + hstepB, voffB); PG8_STAGE(PG8_SA(0, 1), cA + hstepA, voffA);
        if (wr == 1) PG8_BAR;
        PG8_WAIT_V(4); PG8_BAR;
        PG8_STAGE(PG8_SB(1, 0), cB + kstep, voffB); PG8_STAGE(PG8_SA(1, 0), cA + kstep, voffA); PG8_STAGE(PG8_SB(1, 1), cB + hstepB + kstep, voffB);
        PG8_WAIT_V(6); PG8_BAR;
    }
    for (;;) {
        const bool has_next = S.next(ui + 1, nxt);
        const char* nA = has_next ? PG8_BASEA(nxt) : cA; const char* nB = has_next ? PG8_BASEB(nxt) : cB;
        for (int t = 0; t < nt; t += 2) {
            const bool last = (t == nt - 2);
            const char* a1 = cA + (size_t)(t + 1) * kstep;
            const char* a2 = last ? nA : cA + (size_t)(t + 2) * kstep; const char* b2 = last ? nB : cB + (size_t)(t + 2) * kstep;
            const char* a3 = a2 + kstep; const char* b3 = b2 + kstep;
            if (last && has_next) S.a_ready(nxt);
            if constexpr (SP2) {
            PG8_LDB(B0, 0, 0); PG8_LDB(B1, 0, 1); PG8_SCHED; PG8_LDA(At, 0, 0); PG8_STAGE(PG8_SA(1, 1), a1 + hstepA, voffA);
            PG8_WAIT_V(8); PG8_WAIT_L(0); PG8_BAR; PG8_MMA(0, 0, At, B0); PG8_MMA(0, 1, At, B1); PG8_BAR; PG8_SCHED;
            PG8_LDA(At, 0, 1); PG8_STAGE(PG8_SB(0, 0), b2, voffB); PG8_STAGE(PG8_SB(0, 1), b2 + hstepB, voffB); PG8_STAGE(PG8_SA(0, 0), a2, voffA);
            PG8_WAIT_V(8); PG8_WAIT_L(0); PG8_BAR; PG8_MMA(1, 0, At, B0); PG8_MMA(1, 1, At, B1); PG8_BAR; PG8_SCHED;
            PG8_LDB(B0, 1, 0); PG8_LDB(B1, 1, 1); PG8_SCHED; PG8_LDA(At, 1, 0); PG8_STAGE(PG8_SA(0, 1), a2 + hstepA, voffA);
            PG8_WAIT_V(8); PG8_WAIT_L(0); PG8_BAR; PG8_MMA(0, 0, At, B0); PG8_MMA(0, 1, At, B1); PG8_BAR; PG8_SCHED;
            PG8_LDA(At, 1, 1); PG8_STAGE(PG8_SB(1, 0), b3, voffB); PG8_STAGE(PG8_SB(1, 1), b3 + hstepB, voffB); PG8_STAGE(PG8_SA(1, 0), a3, voffA);
            PG8_WAIT_V(8); PG8_WAIT_L(0); PG8_BAR; PG8_MMA(1, 0, At, B0); PG8_MMA(1, 1, At, B1); PG8_BAR; PG8_SCHED;
            } else {
            PG8_LDB(B0, 0, 0); PG8_SCHED; PG8_LDA(At, 0, 0); PG8_STAGE(PG8_SA(1, 1), a1 + hstepA, voffA);
            PG8_WAIT_L(8); PG8_BAR; PG8_WAIT_L(0); PG8_MMA(0, 0, At, B0); PG8_BAR; PG8_SCHED;
            PG8_LDB(B1, 0, 1); PG8_STAGE(PG8_SB(0, 0), b2, voffB);
            PG8_BAR; PG8_WAIT_L(0); PG8_MMA(0, 1, At, B1); PG8_BAR;
            PG8_LDA(At, 0, 1); PG8_STAGE(PG8_SA(0, 0), a2, voffA);
            PG8_BAR; PG8_WAIT_L(0); PG8_MMA(1, 0, At, B0); PG8_BAR; PG8_SCHED;
            PG8_STAGE(PG8_SB(0, 1), b2 + hstepB, voffB);
            PG8_WAIT_V(6); PG8_BAR; PG8_MMA(1, 1, At, B1); PG8_BAR;
            PG8_LDB(B0, 1, 0); PG8_SCHED; PG8_LDA(At, 1, 0); PG8_STAGE(PG8_SA(0, 1), a2 + hstepA, voffA);
            PG8_WAIT_L(8); PG8_BAR; PG8_WAIT_L(0); PG8_MMA(0, 0, At, B0); PG8_BAR; PG8_SCHED;
            PG8_LDB(B1, 1, 1); PG8_STAGE(PG8_SB(1, 0), b3, voffB);
            PG8_BAR; PG8_WAIT_L(0); PG8_MMA(0, 1, At, B1); PG8_BAR;
            PG8_LDA(At, 1, 1); PG8_STAGE(PG8_SA(1, 0), a3, voffA);
            PG8_BAR; PG8_WAIT_L(0); PG8_MMA(1, 0, At, B0); PG8_BAR; PG8_SCHED;
            PG8_STAGE(PG8_SB(1, 1), b3 + hstepB, voffB);
            PG8_WAIT_V(6); PG8_BAR; PG8_MMA(1, 1, At, B1); PG8_BAR;
            }
        }
        if constexpr (ALIGN_EPI) { if (wr == 0) PG8_BAR; }
        if constexpr (!Epi::AFTER_DRAIN) { E(acc, cur, wr, wc, fr, fq); S.done(cur); }
        if (!has_next) break;
#pragma unroll
        for (int a = 0; a < 2; ++a)
#pragma unroll
            for (int b = 0; b < 2; ++b)
#pragma unroll
                for (int m = 0; m < 4; ++m)
#pragma unroll
                    for (int n = 0; n < 2; ++n) acc[a][b][m][n] = (f32x4){0.f, 0.f, 0.f, 0.f};
        cur = nxt; cA = nA; cB = nB; ++ui;
        if constexpr (ALIGN_EPI) { if (wr == 1) PG8_BAR; }
    }
    PG8_WAIT_V(0);
    if constexpr (!ALIGN_EPI) { if (wr == 0) PG8_BAR; }
    PG8_BAR;
    if constexpr (Epi::AFTER_DRAIN) { E.fused(acc, cur, wr, wc, fr, fq, lds, wid, lane); S.done(cur); }
#undef PG8_BASEA
#undef PG8_BASEB
#undef PG8_SA
#undef PG8_SB
#undef PG8_STAGE
#undef PG8_LDA
#undef PG8_LDB
#undef PG8_MMA
#undef PG8_WAIT_V
#undef PG8_WAIT_L
#undef PG8_BAR
#undef PG8_SCHED
}
}

constexpr int NWAVES = 8;
#ifndef MK_N_LAUNCHES
#define MK_N_LAUNCHES 1
#endif
constexpr int N_PHASES = 10;
constexpr int N_LAUNCHES = MK_N_LAUNCHES;

constexpr size_t MiB = 1u << 20, KiB = 1u << 10;
constexpr size_t WS_CTL = 0, CTL_ZERO_BYTES = 32 * KiB;
constexpr size_t WS_RS0 = 1 * MiB, WS_RSM = 1 * MiB + 64 * KiB;
constexpr size_t WS_SSQ1 = 2 * MiB, WS_SSQ2 = 3 * MiB;
constexpr size_t WS_SUMM = 4 * MiB;
constexpr size_t WS_TAB = 6 * MiB;
constexpr size_t WS_WIN = 10 * MiB, WS_WCKV = 15 * MiB;
constexpr size_t WS_WOUT = 17 * MiB, WS_WCQN = 19 * MiB, WS_WCO = 20 * MiB;
constexpr size_t WS_WMI = 21 * MiB, WS_WMO = 29 * MiB;
constexpr size_t WS_BTS = 37 * MiB, WS_BTO = 45 * MiB;
constexpr size_t WS_KVM = 53 * MiB, WS_RGW = 55 * MiB, WS_RGC = 55 * MiB + 512 * KiB;
constexpr size_t WS_XB = 56 * MiB, WS_MEMB = 88 * MiB;
constexpr size_t WS_MIX = 90 * MiB;
constexpr size_t WS_Q = 122 * MiB, WS_K = 138 * MiB, WS_V = 154 * MiB, WS_U = 170 * MiB, WS_G = 186 * MiB;
constexpr size_t WS_OP = 202 * MiB;
constexpr size_t WS_HID = 122 * MiB;
constexpr size_t WS_LSE = 250 * MiB;
constexpr size_t WS_END = 252 * MiB;
static_assert(WS_WIN + (size_t)2560 * 1024 * 2 == WS_WCKV && WS_XB + (size_t)NT * 1024 * 2 == WS_MEMB && WS_HID + (size_t)NT * FF * 2 == WS_LSE, "d_ws map");
constexpr int CW_BAR = 4096;

constexpr int RING_OFF = 0, RING_BYTES = 131072;
constexpr int SCRATCH_BYTES = 139264;
constexpr int LDSCTL_OFF = SCRATCH_BYTES, MISC_OFF = LDSCTL_OFF + 320;
constexpr int LDS_BYTES = SCRATCH_BYTES + 1024;
static_assert(MISC_OFF + 128 <= LDS_BYTES, "LDS map");

#define GAS __attribute__((address_space(1)))
#define LAS __attribute__((address_space(3)))
typedef unsigned short bf16;
typedef unsigned v4u __attribute__((ext_vector_type(4)));
typedef float f32x4 __attribute__((ext_vector_type(4)));
typedef GAS unsigned gu32;
#define RLX_AGENT __ATOMIC_RELAXED, __HIP_MEMORY_SCOPE_AGENT
#define LDS_WAIT() asm volatile("s_waitcnt lgkmcnt(0)" ::: "memory")
#define VM_WAIT() asm volatile("s_waitcnt vmcnt(0)" ::: "memory")
__device__ __forceinline__ unsigned f2bf(float f) { unsigned u = __builtin_bit_cast(unsigned, f); return (u + 0x7fffu + ((u >> 16) & 1u)) >> 16; }
__device__ __forceinline__ unsigned pk2(float lo, float hi) { return f2bf(lo) | (f2bf(hi) << 16); }
__device__ __forceinline__ float bf2f(unsigned short b) { return __builtin_bit_cast(float, (unsigned)b << 16); }
__device__ __forceinline__ float bflo(unsigned w) { return __builtin_bit_cast(float, w << 16); }
__device__ __forceinline__ float bfhi(unsigned w) { return __builtin_bit_cast(float, w & 0xffff0000u); }

#define XB_TMO      128
#define XB_XCNT(j)  (256  + 64 * (j))
#define XB_XSUB(j)  (1280 + 64 * (j))
#define XB_XGEN(j)  (2304 + 64 * (j))
#define XB_TOP      3328
#define XB_TOPGEN   3392
#define XCD_BAR_WORDS 3456
#define XB_SPIN_CAP (1u << 18)

__device__ __forceinline__ unsigned xb_ld(unsigned* p)              { return __hip_atomic_load(p, __ATOMIC_RELAXED, __HIP_MEMORY_SCOPE_AGENT); }
__device__ __forceinline__ unsigned xb_add(unsigned* p, unsigned v) { return __hip_atomic_fetch_add(p, v, __ATOMIC_RELAXED, __HIP_MEMORY_SCOPE_AGENT); }
__device__ __forceinline__ unsigned xb_xcc_id() { return (unsigned)__builtin_amdgcn_s_getreg((3 << 11) | 20) & 0xFu; }
#define XB_SPIN(cond, bar) do { unsigned _sp = 0; while (cond) { __builtin_amdgcn_s_sleep(1); \
    if ((++_sp & 255u) == 0u) { if (xb_ld(&(bar)[XB_TMO])) break; if (_sp > XB_SPIN_CAP) { atomicAdd(&(bar)[XB_TMO], 1u); break; } } } } while (0)

struct XcdBarrier {
    unsigned* bar; unsigned x;
    volatile LAS unsigned* st;
};
__device__ __forceinline__ XcdBarrier xcd_barrier_post(unsigned* bar, volatile LAS unsigned* st, bool tid0) {
    XcdBarrier b; b.bar = bar; b.x = xb_xcc_id(); b.st = st;
    if (tid0) (void)xb_add(&bar[XB_XCNT(b.x)], 1u);
    return b;
}
__device__ __forceinline__ void xcd_barrier_complete(unsigned* bar, unsigned x, unsigned& nloc, unsigned& nx) {
    const unsigned G = gridDim.x * gridDim.y * gridDim.z;
    unsigned sum, cnt, mine, sp = 0u;
    for (;;) {
        sum = 0u; cnt = 0u; mine = 0u;
#pragma unroll
        for (unsigned j = 0; j < 16; ++j) { const unsigned c = xb_ld(&bar[XB_XCNT(j)]); sum += c; cnt += (c > 0u) ? 1u : 0u; mine = (j == x) ? c : mine; }
        if (sum == G) break;
        __builtin_amdgcn_s_sleep(1);
        if ((++sp & 255u) == 0u) { if (xb_ld(&bar[XB_TMO])) break; if (sp > XB_SPIN_CAP) { atomicAdd(&bar[XB_TMO], 1u); break; } }
    }
    nloc = mine > 0u ? mine : 1u; nx = cnt > 0u ? cnt : 1u;
}
__device__ __forceinline__ void xcd_barrier(const XcdBarrier& b, bool tid0) {
    asm volatile("s_waitcnt vmcnt(0)" ::: "memory");
    __syncthreads();
    if (tid0) {
        unsigned* bar = b.bar;
        __builtin_amdgcn_s_waitcnt(0);
        unsigned nloc = b.st[0], nx = b.st[1];
        if (nloc == 0u) { xcd_barrier_complete(bar, b.x, nloc, nx); b.st[0] = nloc; b.st[1] = nx; }
        const unsigned old = xb_add(&bar[XB_XSUB(b.x)], 1u);
        const unsigned gen = old / nloc;
        if (old + 1u == (gen + 1u) * nloc) {
            __builtin_amdgcn_fence(__ATOMIC_RELEASE, "agent");
            asm volatile("s_waitcnt vmcnt(0)" ::: "memory");
            const unsigned og = xb_add(&bar[XB_TOP], 1u);
            const unsigned tg = og / nx;
            if (og + 1u == (tg + 1u) * nx) xb_add(&bar[XB_TOPGEN], 1u);
            else XB_SPIN(xb_ld(&bar[XB_TOPGEN]) == tg, bar);
            __builtin_amdgcn_fence(__ATOMIC_ACQUIRE, "agent");
            xb_add(&bar[XB_XGEN(b.x)], 1u);
            asm volatile("s_waitcnt vmcnt(0)" ::: "memory");
        } else {
            XB_SPIN(xb_ld(&bar[XB_XGEN(b.x)]) == gen, bar);
            __builtin_amdgcn_fence(__ATOMIC_ACQUIRE, "agent");
            asm volatile("s_waitcnt vmcnt(0)" ::: "memory");
        }
    }
    __syncthreads();
}

struct Frame {
    LAS unsigned char* lds;
    volatile LAS unsigned* MISC;
    gu32* ctl;
    int tid, lane, wave;
    int vcu, G;
    unsigned char* ws;
    const float* x; const float* mem; const int* pos; float* out;
    const float *g_mix, *w_in, *conv_w, *conv_b, *a_w, *a_b, *x_w, *x_b, *lam, *w_out, *g_cross, *g_mem, *w_cq, *w_ck, *w_cv, *w_co, *g_mlp, *w_mi, *w_mo, *g_fin;
};
template <class T> __device__ __forceinline__ T* wsp(const Frame& F, size_t off) { return (T*)(F.ws + off); }

__device__ __forceinline__ float wave_sum(float v) {
#pragma unroll
    for (int o = 1; o < 64; o <<= 1) v += __shfl_xor(v, o);
    return v;
}
__device__ __forceinline__ float wave_max(float v) {
#pragma unroll
    for (int o = 1; o < 64; o <<= 1) v = fmaxf(v, __shfl_xor(v, o));
    return v;
}

__device__ __forceinline__ void p0_transpose_item(const float* W, const float* gain, int K, int N, bf16* WT, int row_off, LAS float* scr, int item, int lane) {
    const int nblk = N / 32, kb = item / nblk, nb = item % nblk, k0 = 64 * kb, n0 = 32 * nb;
#pragma unroll 8
    for (int i = 0; i < 32; ++i) { const int kk = 2 * i + (lane >> 5); const float gv = gain ? gain[k0 + kk] : 1.f; scr[kk * 33 + (lane & 31)] = W[(size_t)(k0 + kk) * N + n0 + (lane & 31)] * gv; }
    LDS_WAIT(); asm volatile("" ::: "memory");
    const int c = lane & 7;
#pragma unroll
    for (int j = 0; j < 4; ++j) { const int n = (lane >> 3) + 8 * j; const LAS float* s = scr + (8 * c) * 33 + n;
        v4u o; o.x = pk2(s[0 * 33], s[1 * 33]); o.y = pk2(s[2 * 33], s[3 * 33]); o.z = pk2(s[4 * 33], s[5 * 33]); o.w = pk2(s[6 * 33], s[7 * 33]);
        *(GAS v4u*)(WT + (size_t)(row_off + n0 + n) * K + k0 + 8 * c) = o; }
    LDS_WAIT(); asm volatile("" ::: "memory");
}
__device__ __forceinline__ void row_to_bf16_rs(int lane, const float* xrow, bf16* orow, float* rs) {
    const GAS f32x4* xr = (const GAS f32x4*)xrow + lane;
    f32x4 v[4]; float s = 0.f;
#pragma unroll
    for (int j = 0; j < 4; ++j) { v[j] = xr[64 * j]; s += (v[j].x * v[j].x + v[j].y * v[j].y) + (v[j].z * v[j].z + v[j].w * v[j].w); }
    s = wave_sum(s);
    if (lane == 0) *rs = 1.0f / sqrtf(s * (1.f / DM) + NORM_EPS);
    GAS unsigned long long* o8 = (GAS unsigned long long*)orow + lane;
#pragma unroll
    for (int j = 0; j < 4; ++j) o8[64 * j] = (unsigned long long)pk2(v[j].x, v[j].y) | ((unsigned long long)pk2(v[j].z, v[j].w) << 32);
}
__device__ __forceinline__ void p0_prologue(Frame& F) {
    LAS float* scr = (LAS float*)(F.lds + RING_OFF + F.wave * 16384);
    const int gw = F.vcu * NWAVES + F.wave, NGW = F.G * NWAVES, lane = F.lane;
    bf16* WIN = wsp<bf16>(F, WS_WIN); bf16* WCKV = wsp<bf16>(F, WS_WCKV); bf16* WOUT = wsp<bf16>(F, WS_WOUT); bf16* WCO = wsp<bf16>(F, WS_WCO);
    bf16* WMI = wsp<bf16>(F, WS_WMI); bf16* WMO = wsp<bf16>(F, WS_WMO);
    constexpr int I_IN = 16 * 80, I_CK = 16 * 16, I_OUT = 16 * 32, I_CO = 8 * 32, I_MI = 16 * 128, I_MO = 64 * 32;
    constexpr int NITEMS = I_IN + 2 * I_CK + I_OUT + I_CO + I_MI + I_MO;
    for (int it = gw; it < NITEMS; it += NGW) {
        int r = it;
        if (r < I_MI) { p0_transpose_item(F.w_mi, F.g_mlp, DM, FF, WMI, 0, scr, r, lane); continue; } r -= I_MI;
        if (r < I_MO) { p0_transpose_item(F.w_mo, nullptr, FF, DM, WMO, 0, scr, r, lane); continue; } r -= I_MO;
        if (r < I_IN) { p0_transpose_item(F.w_in, F.g_mix, DM, 2560, WIN, 0, scr, r, lane); continue; } r -= I_IN;
        if (r < I_CK) { p0_transpose_item(F.w_ck, F.g_mem, DM, 512, WCKV, 0, scr, r, lane); continue; } r -= I_CK;
        if (r < I_CK) { p0_transpose_item(F.w_cv, F.g_mem, DM, 512, WCKV, 512, scr, r, lane); continue; } r -= I_CK;
        if (r < I_OUT) { p0_transpose_item(F.w_out, nullptr, DM, DM, WOUT, 0, scr, r, lane); continue; } r -= I_OUT;
        p0_transpose_item(F.w_co, nullptr, 512, DM, WCO, 0, scr, r, lane);
    }
    { bf16* WCQN = wsp<bf16>(F, WS_WCQN); const int gt = gw * 64 + lane, NGT = NGW * 64;
      for (int i = gt; i < 1024 * 512 / 4; i += NGT) { const int k = i >> 7; const f32x4 v = ((const GAS f32x4*)F.w_cq)[i]; const float g = F.g_cross[k];
          ((GAS unsigned long long*)WCQN)[i] = (unsigned long long)pk2(v.x * g, v.y * g) | ((unsigned long long)pk2(v.z * g, v.w * g) << 32); } }
    { bf16* RGW = wsp<bf16>(F, WS_RGW); const int gt = gw * 64 + lane, NGT = NGW * 64;
      for (int i = gt; i < 2 * 2 * 8 * 64 * 64; i += NGT) { const int ii = i & 63, jo = (i >> 6) & 63, gg = (i >> 12) & 7, dir = (i >> 15) & 1, ty = i >> 16; const float* W = ty ? F.x_w : F.a_w;
          RGW[i] = (bf16)f2bf(W[((size_t)(dir * 8 + gg) * 64 + ii) * 64 + jo]); } }
    { float* RGC = wsp<float>(F, WS_RGC); const int gt = gw * 64 + lane; if (gt < 1024) { ((f32x4*)RGC)[gt] = (f32x4){F.a_b[gt], F.x_b[gt], -8.f * 1.4426950408889634f * log1pf(expf(-F.lam[gt])), 0.f}; } }
    { float* TAB = wsp<float>(F, WS_TAB); const int gt = gw * 64 + lane, NGT = NGW * 64;
      for (int i = gt; i < NT * 32; i += NGT) { const int tok = i >> 5, d = i & 31; const float inv = powf(10000.f, -(float)d / 32.f); const float ang = (float)F.pos[tok] * inv;
          float sn, cs; sincosf(ang, &sn, &cs); ((float2*)TAB)[i] = make_float2(cs, sn); } }
    bf16* XB = wsp<bf16>(F, WS_XB); bf16* MEMB = wsp<bf16>(F, WS_MEMB); float* RS0 = wsp<float>(F, WS_RS0); float* RSM = wsp<float>(F, WS_RSM);
    for (int m = gw; m < NT; m += NGW) row_to_bf16_rs(lane, F.x + (size_t)m * DM, XB + (size_t)m * DM, RS0 + m);
    for (int m = gw; m < NB * NMEM; m += NGW) row_to_bf16_rs(lane, F.mem + (size_t)m * DM, MEMB + (size_t)m * DM, RSM + m);
}

__device__ __forceinline__ float dot128_bf16(const bf16* a, const bf16* b) {
    float acc = 0.f;
#pragma unroll 4
    for (int c = 0; c < 16; ++c) { const v4u x = ((const GAS v4u*)a)[c], y = ((const GAS v4u*)b)[c];
        acc += bflo(x.x) * bflo(y.x) + bfhi(x.x) * bfhi(y.x) + bflo(x.y) * bflo(y.y) + bfhi(x.y) * bfhi(y.y) + bflo(x.z) * bflo(y.z) + bfhi(x.z) * bfhi(y.z) + bflo(x.w) * bflo(y.w) + bfhi(x.w) * bfhi(y.w); }
    return acc;
}
typedef short xw_bf16x8 __attribute__((ext_vector_type(8)));
typedef float xw_f32x16 __attribute__((ext_vector_type(16)));
__device__ __forceinline__ void xw_tile(const bf16* X, int ldx, const bf16* Y, int ldy, bf16* OUT, int ldo, float scale, int lane) {
    const int r32 = lane & 31, hi = lane >> 5;
    xw_f32x16 acc[2][2];
#pragma unroll
    for (int ci = 0; ci < 2; ++ci)
#pragma unroll
        for (int ri = 0; ri < 2; ++ri) acc[ci][ri] = (xw_f32x16){};
    const bf16* yp = Y + r32 * ldy + 8 * hi; const bf16* xp = X + r32 * ldx + 8 * hi;
#pragma unroll 2
    for (int s = 0; s < 8; ++s) {
        xw_bf16x8 ya[2], xb[2];
#pragma unroll
        for (int i = 0; i < 2; ++i) { ya[i] = *(const GAS xw_bf16x8*)(yp + 32 * i * ldy + 16 * s); xb[i] = *(const GAS xw_bf16x8*)(xp + 32 * i * ldx + 16 * s); }
#pragma unroll
        for (int ci = 0; ci < 2; ++ci)
#pragma unroll
            for (int ri = 0; ri < 2; ++ri) acc[ci][ri] = __builtin_amdgcn_mfma_f32_32x32x16_bf16(ya[ci], xb[ri], acc[ci][ri], 0, 0, 0);
    }
#pragma unroll
    for (int ci = 0; ci < 2; ++ci)
#pragma unroll
        for (int ri = 0; ri < 2; ++ri)
#pragma unroll
            for (int rq = 0; rq < 4; ++rq) {
                const int c = 32 * ci + 8 * rq + 4 * hi, r = 32 * ri + r32;
                const unsigned lo = pg8::cvt_pk_bf16(acc[ci][ri][4 * rq] * scale, acc[ci][ri][4 * rq + 1] * scale), hh = pg8::cvt_pk_bf16(acc[ci][ri][4 * rq + 2] * scale, acc[ci][ri][4 * rq + 3] * scale);
                *(GAS unsigned long long*)(OUT + (size_t)r * ldo + c) = (unsigned long long)lo | ((unsigned long long)hh << 32);
            }
}
__device__ __forceinline__ void p2_cross_weights(Frame& F) {
    const bf16* KVM = wsp<bf16>(F, WS_KVM); const bf16* WCQN = wsp<bf16>(F, WS_WCQN); const bf16* WCO = wsp<bf16>(F, WS_WCO);
    bf16* BTS = wsp<bf16>(F, WS_BTS); bf16* BTO = wsp<bf16>(F, WS_BTO);
    const int gw = F.vcu * NWAVES + F.wave, NGW = F.G * NWAVES;
    for (int u = gw; u < 2048; u += NGW) {
        int lane = F.lane; asm volatile("" : "+v"(lane));
        const int t = u & 1023, bh = t >> 6, b = bh >> 2, h = bh & 3, q = t & 63;
        if (u < 1024) { const int mt = q & 3, kt = q >> 2;
            xw_tile(KVM + (size_t)(b * NMEM + 64 * mt) * 1024 + h * 128, 1024, WCQN + (size_t)(64 * kt) * 512 + h * 128, 512, BTS + ((size_t)b * 1024 + h * 256 + 64 * mt) * 1024 + 64 * kt, 1024, CSCALE, lane); }
        else { const int mt = q & 3, nt = q >> 2;
            xw_tile(WCO + (size_t)(64 * nt) * 512 + h * 128, 512, KVM + (size_t)(b * NMEM + 64 * mt) * 1024 + 512 + h * 128, 1024, BTO + ((size_t)b * 1024 + 64 * nt) * 1024 + h * 256 + 64 * mt, 1024, 1.0f, lane); }
    }
}
__device__ __forceinline__ void p2_attn_simple(Frame& F) {
    const bf16* Q = wsp<bf16>(F, WS_Q); const bf16* K = wsp<bf16>(F, WS_K); const bf16* V = wsp<bf16>(F, WS_V); bf16* MIX = wsp<bf16>(F, WS_MIX);
    const int gw = F.vcu * NWAVES + F.wave, NGW = F.G * NWAVES, lane = F.lane;
    for (int u = gw; u < NT * 8; u += NGW) {
        const int h = u & 7, tok = u >> 3, b = tok >> 12, t = tok & (SEQ - 1);
        const float qd = bf2f(Q[(size_t)tok * 512 + h * 64 + lane]);
        float s[9];
#pragma unroll
        for (int pi = 0; pi < 3; ++pi) {
            const int dil = pi == 0 ? 1 : (pi == 1 ? 4 : 16);
#pragma unroll
            for (int r = 0; r < 3; ++r) {
                const int jj = r * 64 + lane, tk = t + (jj - 64) * dil;
                const bool val = (jj < 129) && tk >= 0 && tk < SEQ;
                const GAS v4u* kp = (const GAS v4u*)(K + (size_t)(b * SEQ + (val ? tk : t)) * 512 + h * 64);
                float acc = 0.f;
#pragma unroll
                for (int c = 0; c < 8; ++c) { const v4u x = kp[c];
                    acc += __shfl(qd, 8 * c + 0) * bflo(x.x) + __shfl(qd, 8 * c + 1) * bfhi(x.x) + __shfl(qd, 8 * c + 2) * bflo(x.y) + __shfl(qd, 8 * c + 3) * bfhi(x.y)
                         + __shfl(qd, 8 * c + 4) * bflo(x.z) + __shfl(qd, 8 * c + 5) * bfhi(x.z) + __shfl(qd, 8 * c + 6) * bflo(x.w) + __shfl(qd, 8 * c + 7) * bfhi(x.w); }
                s[pi * 3 + r] = val ? acc : -1e30f;
            }
        }
        float m = s[0];
#pragma unroll
        for (int i = 1; i < 9; ++i) m = fmaxf(m, s[i]);
        m = wave_max(m);
        float den = 0.f;
#pragma unroll
        for (int i = 0; i < 9; ++i) { s[i] = exp2f(s[i] - m); den += s[i]; }
        den = wave_sum(den);
        float o = 0.f;
#pragma unroll
        for (int pi = 0; pi < 3; ++pi) {
            const int dil = pi == 0 ? 1 : (pi == 1 ? 4 : 16);
            for (int jj = 0; jj < 129; ++jj) {
                const int tk = t + (jj - 64) * dil; const int r = jj >> 6;
                const float pr = r == 0 ? s[pi * 3] : (r == 1 ? s[pi * 3 + 1] : s[pi * 3 + 2]);
                const float pj = __shfl(pr, jj & 63);
                if (tk >= 0 && tk < SEQ) o += pj * bf2f(V[(size_t)(b * SEQ + tk) * 512 + h * 64 + lane]);
            }
        }
        MIX[(size_t)tok * 1024 + h * 64 + lane] = (bf16)f2bf(o / den);
    }
}

typedef short bf16x8_t __attribute__((ext_vector_type(8)));
typedef short s16x4_t __attribute__((ext_vector_type(4)));
typedef float f32x16_t __attribute__((ext_vector_type(16)));
constexpr int AT_NK = 384, AT_K_OFF = 0, AT_V_OFF = AT_NK * 128, AT_VH = AT_NK * 64 + 64, AT_WS_OFF = AT_V_OFF + 2 * AT_VH, AT_WS_PER_WAVE = 256 + 4096;
static_assert(AT_WS_OFF % 16 == 0 && AT_WS_OFF + NWAVES * AT_WS_PER_WAVE <= SCRATCH_BYTES, "attention LDS map");
__device__ __forceinline__ int crow16(int r, int hi) { return (r & 3) + 8 * (r >> 2) + 4 * hi; }
__device__ __forceinline__ void p2_attn_mfma(Frame& F) {
    const bf16* Q = wsp<bf16>(F, WS_Q); const bf16* K = wsp<bf16>(F, WS_K); const bf16* V = wsp<bf16>(F, WS_V);
    bf16* OP = wsp<bf16>(F, WS_OP); float* LSE = wsp<float>(F, WS_LSE);
    const int lane = F.lane, w = F.wave, r32 = lane & 31, hi = lane >> 5;
    LAS unsigned char* lds = F.lds;
    LAS float* wsf = (LAS float*)(lds + AT_WS_OFF + w * AT_WS_PER_WAVE);
    LAS bf16* stg = (LAS bf16*)(lds + AT_WS_OFF + w * AT_WS_PER_WAVE + 256);
    const int xcd = F.vcu >> 5, wl = F.vcu & 31;
    v4u kv[6], vv[6];
#define AT_DECODE(it_) const int uu = wl + 32 * (it_), bh = xcd * 4 + uu / 48, rem = uu % 48, pat = rem >> 4, blk = rem & 15; \
        const int b = bh >> 3, h = bh & 7; const int dil = pat == 0 ? 1 : (pat == 1 ? 4 : 16), L = SEQ / dil; \
        const int cls = pat == 0 ? 0 : (pat == 1 ? (blk >> 2) : blk), i0 = pat == 0 ? blk * 256 : (pat == 1 ? (blk & 3) * 256 : 0);
#define AT_PREFETCH(it_) do { AT_DECODE(it_) const bf16* Kb = K + (size_t)(b * SEQ + cls) * 512 + h * 64; const bf16* Vb = V + (size_t)(b * SEQ + cls) * 512 + h * 64; \
        _Pragma("unroll") for (int k = 0; k < 6; ++k) { const int idx = tid + 512 * k, row = idx >> 3, c = idx & 7, pos = i0 - 64 + row; const bool ok = pos >= 0 && pos < L; \
            const int off = (ok ? pos : 0) * dil * 512 + c * 8; \
            kv[k] = *(const GAS v4u*)(Kb + off); vv[k] = *(const GAS v4u*)(Vb + off); } } while (0)
    { const int tid = F.tid; AT_PREFETCH(0); }
    for (int it = 0; it < 6; ++it) {
        AT_DECODE(it)
        int tid = F.tid; asm volatile("" : "+v"(tid));
        const int qpos = i0 + 32 * w + r32;
        const size_t qtok = (size_t)(b * SEQ + qpos * dil + cls);
        bf16x8_t qr[4];
#pragma unroll
        for (int s = 0; s < 4; ++s) qr[s] = *(const GAS bf16x8_t*)(Q + qtok * 512 + h * 64 + 16 * s + 8 * hi);
#pragma unroll
        for (int k = 0; k < 6; ++k) {
            const int idx = tid + 512 * k, row = idx >> 3, c = idx & 7, pos = i0 - 64 + row;
            const bool ok = pos >= 0 && pos < L; const v4u z = {0u, 0u, 0u, 0u};
            *(LAS v4u*)(lds + AT_K_OFF + row * 128 + ((c ^ ((row >> 1) & 7)) << 4)) = ok ? kv[k] : z;
            *(LAS v4u*)(lds + AT_V_OFF + (c >> 2) * AT_VH + row * 64 + (c & 3) * 16) = ok ? vv[k] : z;
        }
        __syncthreads();
        AT_PREFETCH(it + 1 < 6 ? it + 1 : 5);
        f32x16_t S[5];
#pragma unroll
        for (int kt = 0; kt < 5; ++kt) {
            const int row = 32 * w + 32 * kt + r32;
            f32x16_t acc = {};
#pragma unroll
            for (int s = 0; s < 4; ++s) {
                const bf16x8_t kf = *(const LAS bf16x8_t*)(lds + AT_K_OFF + row * 128 + (((2 * s + hi) ^ ((row >> 1) & 7)) << 4));
                acc = __builtin_amdgcn_mfma_f32_32x32x16_bf16(kf, qr[s], acc, 0, 0, 0);
            }
            S[kt] = acc; __builtin_amdgcn_sched_barrier(0);
        }
        float mx = -1e30f;
#pragma unroll
        for (int kt = 0; kt < 5; ++kt)
#pragma unroll
            for (int r = 0; r < 16; ++r) {
                const int cr = crow16(r, hi), kpos = i0 - 64 + 32 * w + 32 * kt + cr;
                bool ok = kpos >= 0 && kpos < L;
                if (kt == 0) ok = ok && cr >= r32;
                if (kt == 4) ok = ok && cr <= r32;
                const float v = ok ? S[kt][r] : -1e30f;
                S[kt][r] = v; mx = fmaxf(mx, v);
            }
        mx = fmaxf(mx, __shfl_xor(mx, 32));
        float lsum = 0.f;
#pragma unroll
        for (int kt = 0; kt < 5; ++kt)
#pragma unroll
            for (int r = 0; r < 16; ++r) { const float p = __builtin_amdgcn_exp2f(S[kt][r] - mx); S[kt][r] = p; lsum += p; }
        lsum += __shfl_xor(lsum, 32);
        f32x16_t o[2]; o[0] = (f32x16_t){}; o[1] = (f32x16_t){};
        const int vlane = ((lane >> 4) & 1) * 32 + (lane & 3) * 8 + (4 * hi + ((lane & 15) >> 2)) * 64;
#pragma unroll
        for (int kt = 0; kt < 5; ++kt)
#pragma unroll
            for (int ss = 0; ss < 2; ++ss) {
                unsigned pw[4];
#pragma unroll
                for (int j = 0; j < 4; ++j) pw[j] = pg8::cvt_pk_bf16(S[kt][8 * ss + 2 * j], S[kt][8 * ss + 2 * j + 1]);
                const v4u pwv = {pw[0], pw[1], pw[2], pw[3]};
                const bf16x8_t pa = __builtin_bit_cast(bf16x8_t, pwv);
                const int rowb = (32 * w + 32 * kt + 16 * ss) * 64;
#pragma unroll
                for (int dh = 0; dh < 2; ++dh) {
                    LAS unsigned char* vp = lds + AT_V_OFF + dh * AT_VH + rowb + vlane;
                    const s16x4_t lo = __builtin_bit_cast(s16x4_t, __builtin_amdgcn_ds_read_tr16_b64_v4i16((LAS s16x4_t*)vp));
                    const s16x4_t hh = __builtin_bit_cast(s16x4_t, __builtin_amdgcn_ds_read_tr16_b64_v4i16((LAS s16x4_t*)(vp + 512)));
                    const bf16x8_t vf = {lo[0], lo[1], lo[2], lo[3], hh[0], hh[1], hh[2], hh[3]};
                    o[dh] = __builtin_amdgcn_mfma_f32_32x32x16_bf16(pa, vf, o[dh], 0, 0, 0);
                }
            }
        if (hi == 0) { wsf[r32] = lsum; LSE[((size_t)pat * NT + qtok) * 8 + h] = mx + __builtin_amdgcn_logf(lsum); }
        LDS_WAIT();
#pragma unroll
        for (int r = 0; r < 16; ++r) {
            const int qrow = crow16(r, hi); const float rl = __builtin_amdgcn_rcpf(wsf[qrow]);
            stg[qrow * 64 + r32] = (bf16)f2bf(o[0][r] * rl); stg[qrow * 64 + 32 + r32] = (bf16)f2bf(o[1][r] * rl);
        }
        LDS_WAIT();
#pragma unroll
        for (int i = 0; i < 4; ++i) {
            const int row = i * 8 + (lane >> 3), ch = lane & 7;
            const v4u v = *(const LAS v4u*)(stg + row * 64 + ch * 8);
            const size_t otok = (size_t)(b * SEQ + (i0 + 32 * w + row) * dil + cls);
            *(GAS v4u*)(OP + ((size_t)pat * NT + otok) * 512 + h * 64 + ch * 8) = v;
        }
        __syncthreads();
    }
}
__device__ __forceinline__ void p3_attn_merge(Frame& F) {
    const bf16* OP = wsp<bf16>(F, WS_OP); const float* LSE = wsp<float>(F, WS_LSE); bf16* MIX = wsp<bf16>(F, WS_MIX);
    const int gt = (F.vcu * NWAVES + F.wave) * 64 + F.lane, NGT = F.G * NWAVES * 64;
    for (int i = gt; i < NT * 64; i += NGT) {
        const int c = i & 7, h = (i >> 3) & 7, tok = i >> 6;
        const float l0 = LSE[((size_t)0 * NT + tok) * 8 + h], l1 = LSE[((size_t)1 * NT + tok) * 8 + h], l2 = LSE[((size_t)2 * NT + tok) * 8 + h];
        const float mm = fmaxf(fmaxf(l0, l1), l2);
        float w0 = exp2f(l0 - mm), w1 = exp2f(l1 - mm), w2 = exp2f(l2 - mm);
        const float inv = 1.0f / (w0 + w1 + w2); w0 *= inv; w1 *= inv; w2 *= inv;
        const size_t off = (size_t)tok * 512 + h * 64 + c * 8;
        const v4u a = *(const GAS v4u*)(OP + off), bq = *(const GAS v4u*)(OP + (size_t)NT * 512 + off), cq = *(const GAS v4u*)(OP + (size_t)2 * NT * 512 + off);
        v4u o;
        o.x = pk2(w0 * bflo(a.x) + w1 * bflo(bq.x) + w2 * bflo(cq.x), w0 * bfhi(a.x) + w1 * bfhi(bq.x) + w2 * bfhi(cq.x));
        o.y = pk2(w0 * bflo(a.y) + w1 * bflo(bq.y) + w2 * bflo(cq.y), w0 * bfhi(a.y) + w1 * bfhi(bq.y) + w2 * bfhi(cq.y));
        o.z = pk2(w0 * bflo(a.z) + w1 * bflo(bq.z) + w2 * bflo(cq.z), w0 * bfhi(a.z) + w1 * bfhi(bq.z) + w2 * bfhi(cq.z));
        o.w = pk2(w0 * bflo(a.w) + w1 * bflo(bq.w) + w2 * bflo(cq.w), w0 * bfhi(a.w) + w1 * bfhi(bq.w) + w2 * bfhi(cq.w));
        *(GAS v4u*)(MIX + (size_t)tok * 1024 + h * 64 + c * 8) = o;
    }
}
__device__ __forceinline__ float rg_conv_at(const bf16* U, const float (&cw)[4], float cb, int b, int tt, int ch) {
    float acc = cb;
#pragma unroll
    for (int k = 0; k < 4; ++k) { const int t2 = tt + k - 2; if (t2 >= 0 && t2 < SEQ) acc += cw[k] * bf2f(U[(size_t)(b * SEQ + t2) * 512 + ch]); }
    return acc;
}
__device__ __forceinline__ void rg_gate(float ucv, const float* aw, const float* xw, float ab, float xb, float sp, int lane, float& a, float& bb) {
    float pa = ab, px = xb;
#pragma unroll 16
    for (int i = 0; i < 64; ++i) { const float uu = __shfl(ucv, i); pa += uu * aw[i * 64 + lane]; px += uu * xw[i * 64 + lane]; }
    const float r = 1.f / (1.f + expf(-pa)), ig = 1.f / (1.f + expf(-px));
    const float la = -8.f * r * sp;
    a = expf(la);
    bb = sqrtf(-expm1f(2.f * la)) * (ig * ucv);
}
__device__ __forceinline__ void p2_rg1_simple(Frame& F) {
    const bf16* U = wsp<bf16>(F, WS_U); float* SUMM = wsp<float>(F, WS_SUMM);
    const int gw = F.vcu * NWAVES + F.wave, NGW = F.G * NWAVES, lane = F.lane;
    for (int u = gw; u < NB * 64 * 2 * 8; u += NGW) {
        const int g = u & 7, dir = (u >> 3) & 1, j = (u >> 4) & 63, b = u >> 10, ch = g * 64 + lane;
        float cw[4];
_Pragma("unroll") for (int k = 0; k < 4; ++k) cw[k] = F.conv_w[k * 512 + ch];
        const float cb = F.conv_b[ch], ab = F.a_b[dir * 512 + ch], xb = F.x_b[dir * 512 + ch], sp = log1pf(expf(-F.lam[dir * 512 + ch]));
        const float* aw = F.a_w + (size_t)(dir * 8 + g) * 4096; const float* xw = F.x_w + (size_t)(dir * 8 + g) * 4096;
        float A = 1.f, H = 0.f;
        for (int i = 0; i < 64; ++i) {
            const int tt = j * 64 + (dir == 0 ? i : 63 - i);
            const float ucv = rg_conv_at(U, cw, cb, b, tt, ch);
            float a, bb; rg_gate(ucv, aw, xw, ab, xb, sp, lane, a, bb);
            H = a * H + bb; A *= a;
        }
        float* o = SUMM + ((((size_t)b * 64 + j) * 2 + dir) * 512 + ch) * 2; o[0] = A; o[1] = H;
    }
}
__device__ __forceinline__ void p3_rg2_simple(Frame& F) {
    const bf16* U = wsp<bf16>(F, WS_U); const bf16* G = wsp<bf16>(F, WS_G); const float* SUMM = wsp<float>(F, WS_SUMM); float* HF = wsp<float>(F, WS_Q);     bf16* MIX = wsp<bf16>(F, WS_MIX);
    const int gw = F.vcu * NWAVES + F.wave, NGW = F.G * NWAVES, lane = F.lane;
    for (int u = gw; u < NB * 64 * 8; u += NGW) {
        const int g = u & 7, j = (u >> 3) & 63, b = u >> 9, ch = g * 64 + lane;
        float cw[4];
_Pragma("unroll") for (int k = 0; k < 4; ++k) cw[k] = F.conv_w[k * 512 + ch];
        const float cb = F.conv_b[ch];
#pragma unroll
        for (int dir = 0; dir < 2; ++dir) {
            const float ab = F.a_b[dir * 512 + ch], xb = F.x_b[dir * 512 + ch], sp = log1pf(expf(-F.lam[dir * 512 + ch]));
            const float* aw = F.a_w + (size_t)(dir * 8 + g) * 4096; const float* xw = F.x_w + (size_t)(dir * 8 + g) * 4096;
            float hc = 0.f;
            if (dir == 0) { for (int q = 0; q < j; ++q) { const float* s = SUMM + ((((size_t)b * 64 + q) * 2 + 0) * 512 + ch) * 2; hc = s[0] * hc + s[1]; } }
            else { for (int q = 63; q > j; --q) { const float* s = SUMM + ((((size_t)b * 64 + q) * 2 + 1) * 512 + ch) * 2; hc = s[0] * hc + s[1]; } }
            for (int i = 0; i < 64; ++i) {
                const int tt = j * 64 + (dir == 0 ? i : 63 - i);
                const float ucv = rg_conv_at(U, cw, cb, b, tt, ch);
                float a, bb; rg_gate(ucv, aw, xw, ab, xb, sp, lane, a, bb);
                hc = a * hc + bb;
                const size_t tok = (size_t)b * SEQ + tt;
                if (dir == 0) HF[tok * 512 + ch] = hc;
                else MIX[tok * 1024 + 512 + ch] = (bf16)f2bf((HF[tok * 512 + ch] + hc) * bf2f(G[tok * 512 + ch]));
            }
        }
    }
}

typedef float f32x4_t __attribute__((ext_vector_type(4)));
__device__ __forceinline__ float bf16_elem(const v4u& v, int e) { const unsigned w = (e >> 1) == 0 ? v.x : (e >> 1) == 1 ? v.y : (e >> 1) == 2 ? v.z : v.w; return (e & 1) ? bfhi(w) : bflo(w); }
constexpr int RG_W_OFF = 65536, RG_CX_OFF = 98304;
static_assert(RG_CX_OFF + 16384 <= SCRATCH_BYTES, "RG LDS map");
typedef float f32x2_t __attribute__((ext_vector_type(2)));
template <int PASS> __device__ __forceinline__ void rg_phase(Frame& F) {
    if (F.vcu >= 256) return;
    int lane = F.lane; asm volatile("" : "+v"(lane));
    const int c = F.vcu & 7, g = (F.vcu >> 3) & 7, b = F.vcu >> 6, w = F.wave, j = 8 * c + w, fr = lane & 15, fq = lane >> 4, tid = w * 64 + lane;
    LAS unsigned char* lds = F.lds; LAS unsigned char* wl = lds + w * 8192;
    const bf16* U = wsp<bf16>(F, WS_U); const bf16* RGW = wsp<bf16>(F, WS_RGW);
    v4u wreg[4];
#pragma unroll
    for (int k = 0; k < 4; ++k) { const int idx = tid + 512 * k, mat = idx >> 9, r = (idx >> 3) & 63, cc = idx & 7; wreg[k] = *(const GAS v4u*)(RGW + ((mat * 8 + g) * 64 + r) * 64 + cc * 8); }
    f32x2_t sm[2][8];
    if (PASS == 2) {
        const GAS f32x2_t* S2 = (const GAS f32x2_t*)wsp<float>(F, WS_SUMM) + ((size_t)(b * 64 + 8 * w) * 2) * 512 + 64 * g + lane;
#pragma unroll
        for (int q = 0; q < 8; ++q) { sm[0][q] = S2[(q * 2 + 0) * 512]; sm[1][q] = S2[(q * 2 + 1) * 512]; }
    }
    {
        const int cc = lane & 7, tg = lane >> 3, chb = 64 * g + 8 * cc, t0 = j * 64 + 8 * tg;
        f32x4_t cw[4][2], cb[2];
#pragma unroll
        for (int k = 0; k < 4; ++k) { cw[k][0] = *(const GAS f32x4_t*)(F.conv_w + k * 512 + chb); cw[k][1] = *(const GAS f32x4_t*)(F.conv_w + k * 512 + chb + 4); }
        cb[0] = *(const GAS f32x4_t*)(F.conv_b + chb); cb[1] = *(const GAS f32x4_t*)(F.conv_b + chb + 4);
        v4u rows[11]; const bf16* Ub = U + (size_t)b * SEQ * 512;
#pragma unroll
        for (int i = 0; i < 11; ++i) { const int tt = t0 - 2 + i; const int tc = tt < 0 ? 0 : (tt >= SEQ ? SEQ - 1 : tt); rows[i] = *(const GAS v4u*)(Ub + (tc * 512 + chb)); }
#pragma unroll
        for (int i = 0; i < 11; ++i) { const int tt = t0 - 2 + i; if (tt < 0 || tt >= SEQ) rows[i] = (v4u){0u, 0u, 0u, 0u}; }
#pragma unroll
        for (int k = 0; k < 8; ++k) {
            float o[8];
#pragma unroll
            for (int e = 0; e < 8; ++e) { float acc = cb[e >> 2][e & 3];
#pragma unroll
                for (int d = 0; d < 4; ++d) acc += cw[d][e >> 2][e & 3] * bf16_elem(rows[k + d], e);
                o[e] = acc; }
            const v4u pk = {pk2(o[0], o[1]), pk2(o[2], o[3]), pk2(o[4], o[5]), pk2(o[6], o[7])};
            const int row = 8 * tg + k;
            *(LAS v4u*)(wl + row * 128 + ((cc ^ ((row >> 1) & 7)) << 4)) = pk;
        }
    }
#pragma unroll
    for (int k = 0; k < 4; ++k) { const int idx = tid + 512 * k, mat = idx >> 9, r = (idx >> 3) & 63, cc = idx & 7; *(LAS v4u*)(lds + RG_W_OFF + mat * 8192 + r * 128 + ((cc ^ ((r >> 1) & 7)) << 4)) = wreg[k]; }
    LAS f32x2_t* CT = (LAS f32x2_t*)(lds + RG_CX_OFF);
    LAS f32x2_t* CR = (LAS f32x2_t*)(lds + RG_CX_OFF + 8192);
    if (PASS == 2) {
        float A0 = 1.f, H0 = 0.f, A1 = 1.f, H1 = 0.f;
#pragma unroll
        for (int q = 0; q < 8; ++q) { H0 = sm[0][q].x * H0 + sm[0][q].y; A0 *= sm[0][q].x; }
#pragma unroll
        for (int q = 7; q >= 0; --q) { H1 = sm[1][q].x * H1 + sm[1][q].y; A1 *= sm[1][q].x; }
        CT[(w * 2 + 0) * 64 + lane] = (f32x2_t){A0, H0}; CT[(w * 2 + 1) * 64 + lane] = (f32x2_t){A1, H1};
        if (w == c) {
#pragma unroll
            for (int q = 0; q < 8; ++q) { CR[(q * 2 + 0) * 64 + lane] = sm[0][q]; CR[(q * 2 + 1) * 64 + lane] = sm[1][q]; }
        }
    }
    __syncthreads();
    float c0 = 0.f, c1 = 0.f;
    if (PASS == 2) {
        for (int cc = 0; cc < c; ++cc) { const f32x2_t s = CT[(cc * 2 + 0) * 64 + lane]; c0 = s.x * c0 + s.y; }
        for (int q = 0; q < w; ++q) { const f32x2_t s = CR[(q * 2 + 0) * 64 + lane]; c0 = s.x * c0 + s.y; }
        for (int cc = 7; cc > c; --cc) { const f32x2_t s = CT[(cc * 2 + 1) * 64 + lane]; c1 = s.x * c1 + s.y; }
        for (int q = 7; q > w; --q) { const f32x2_t s = CR[(q * 2 + 1) * 64 + lane]; c1 = s.x * c1 + s.y; }
    }
    const f32x4_t* RGC = (const f32x4_t*)wsp<float>(F, WS_RGC);
    const bf16* Gb = wsp<bf16>(F, WS_G) + ((size_t)b * SEQ + j * 64) * 512 + 64 * g;
    bf16* Mb = wsp<bf16>(F, WS_MIX) + ((size_t)b * SEQ + j * 64) * 1024 + 512 + 64 * g;
#pragma unroll 1
    for (int np = 0; np < 2; ++np) {
        int lane_np = lane; asm volatile("" : "+v"(lane_np));
        const int lane = lane_np, fr = lane & 15, fq = lane >> 4;
        f32x4_t bt[2][2];
#pragma unroll
        for (int dir = 0; dir < 2; ++dir)
#pragma unroll
            for (int n = 0; n < 2; ++n) bt[dir][n] = RGC[dir * 512 + 64 * g + 32 * np + 16 * n + fr];
        float gv[4][2][4];
        if (PASS == 2) {
#pragma unroll
            for (int m = 0; m < 4; ++m)
#pragma unroll
                for (int n = 0; n < 2; ++n)
#pragma unroll
                    for (int e = 0; e < 4; ++e) gv[m][n][e] = bf2f(*(const GAS unsigned short*)(Gb + ((16 * m + 4 * fq + e) * 512 + 32 * np + 16 * n + fr)));
        }
        float hf[4][2][4];
#pragma unroll
        for (int dir = 0; dir < 2; ++dir) {
            float carry[2], At[2], Ht[2];
#pragma unroll
            for (int n = 0; n < 2; ++n) { At[n] = 1.f; Ht[n] = 0.f; carry[n] = __shfl(dir == 0 ? c0 : c1, 16 * (2 * np + n) + fr); }
            bf16x8_t wf[2][2][2];
#pragma unroll
            for (int ty = 0; ty < 2; ++ty)
#pragma unroll
                for (int n = 0; n < 2; ++n)
#pragma unroll
                    for (int ks = 0; ks < 2; ++ks) { const int row = 32 * np + 16 * n + fr; wf[ty][n][ks] = *(const LAS bf16x8_t*)(lds + RG_W_OFF + (ty * 2 + dir) * 8192 + row * 128 + (((fq + 4 * ks) ^ ((row >> 1) & 7)) << 4)); }
#pragma unroll
            for (int mi = 0; mi < 4; ++mi) {
                const int m = dir == 0 ? mi : 3 - mi;
                bf16x8_t af[2];
#pragma unroll
                for (int ks = 0; ks < 2; ++ks) { const int row = 16 * m + fr; af[ks] = *(const LAS bf16x8_t*)(wl + row * 128 + (((fq + 4 * ks) ^ ((row >> 1) & 7)) << 4)); }
                f32x4_t acc[2][2];
#pragma unroll
                for (int ty = 0; ty < 2; ++ty)
#pragma unroll
                    for (int n = 0; n < 2; ++n) { f32x4_t a = {0.f, 0.f, 0.f, 0.f};
#pragma unroll
                        for (int ks = 0; ks < 2; ++ks) a = __builtin_amdgcn_mfma_f32_16x16x32_bf16(af[ks], wf[ty][n][ks], a, 0, 0, 0);
                        acc[ty][n] = a; }
#pragma unroll
                for (int n = 0; n < 2; ++n) {
                    const int chl = 32 * np + 16 * n + fr;
                    float av[4], bv[4];
#pragma unroll
                    for (int e = 0; e < 4; ++e) {
                        const int row = 16 * m + 4 * fq + e;
                        const float ucv = bf2f(*(const LAS unsigned short*)(wl + row * 128 + (((chl >> 3) ^ ((row >> 1) & 7)) << 4) + (chl & 7) * 2));
                        const float r = __builtin_amdgcn_rcpf(1.f + __builtin_amdgcn_exp2f(-1.4426950408889634f * (acc[0][n][e] + bt[dir][n][0])));
                        const float ig = __builtin_amdgcn_rcpf(1.f + __builtin_amdgcn_exp2f(-1.4426950408889634f * (acc[1][n][e] + bt[dir][n][1])));
                        const float la2 = bt[dir][n][2] * r;
                        const float a = __builtin_amdgcn_exp2f(la2);
                        const float x2 = 2.f * 0.6931471805599453f * la2;
                        const float poly = x2 * (1.f + x2 * (0.5f + x2 * (0.16666667f + x2 * (0.041666668f + x2 * (0.0083333338f + x2 * 0.0013888889f)))));
                        const float em = x2 > -0.25f ? poly : a * a - 1.f;
                        av[e] = a; bv[e] = __builtin_amdgcn_sqrtf(-em) * (ig * ucv);
                    }
                    float Ai = 1.f, Hi = 0.f;
#pragma unroll
                    for (int ee = 0; ee < 4; ++ee) { const int e = dir == 0 ? ee : 3 - ee; Hi = av[e] * Hi + bv[e]; Ai *= av[e]; }
                    const int s1 = (dir == 0 ? lane - 16 : lane + 16) & 63, s2 = (dir == 0 ? lane - 32 : lane + 32) & 63;
                    const bool has1 = dir == 0 ? fq >= 1 : fq <= 2, has2 = dir == 0 ? fq >= 2 : fq <= 1;
                    { const float Ap = __shfl(Ai, s1), Hp = __shfl(Hi, s1); if (has1) { Hi = Ai * Hp + Hi; Ai = Ap * Ai; } }
                    { const float Ap = __shfl(Ai, s2), Hp = __shfl(Hi, s2); if (has2) { Hi = Ai * Hp + Hi; Ai = Ap * Ai; } }
                    const int lt = dir == 0 ? 48 + fr : fr;
                    const float Atot = __shfl(Ai, lt), Htot = __shfl(Hi, lt);
                    if (PASS == 1) { Ht[n] = Atot * Ht[n] + Htot; At[n] *= Atot; }
                    else {
                        float Aex = __shfl(Ai, s1), Hex = __shfl(Hi, s1);
                        if (!has1) { Aex = 1.f; Hex = 0.f; }
                        float h = Aex * carry[n] + Hex;
#pragma unroll
                        for (int ee = 0; ee < 4; ++ee) { const int e = dir == 0 ? ee : 3 - ee; h = av[e] * h + bv[e];
                            if (dir == 0) hf[m][n][e] = h;
                            else *(GAS unsigned short*)(Mb + ((16 * m + 4 * fq + e) * 1024 + chl)) = (unsigned short)f2bf((hf[m][n][e] + h) * gv[m][n][e]); }
                        carry[n] = Atot * carry[n] + Htot;
                    }
                }
            }
            if (PASS == 1 && fq == 0) {
                float2* S2 = (float2*)wsp<float>(F, WS_SUMM);
#pragma unroll
                for (int n = 0; n < 2; ++n) S2[((size_t)(b * 64 + j) * 2 + dir) * 512 + 64 * g + 32 * np + 16 * n + fr] = make_float2(At[n], Ht[n]);
            }
        }
    }
    __syncthreads();
}
__device__ __forceinline__ void p9_final(Frame& F, float* dst) {
    const int gw = F.vcu * NWAVES + F.wave, NGW = F.G * NWAVES, lane = F.lane;
    for (int m = gw; m < NT; m += NGW) {
        GAS f32x4* p = (GAS f32x4*)(F.out + (size_t)m * DM) + lane; GAS f32x4* q = (GAS f32x4*)(dst + (size_t)m * DM) + lane;
        f32x4 v[4]; float s = 0.f;
#pragma unroll
        for (int j = 0; j < 4; ++j) { v[j] = p[64 * j]; s += (v[j].x * v[j].x + v[j].y * v[j].y) + (v[j].z * v[j].z + v[j].w * v[j].w); }
        s = wave_sum(s);
        const float r = 1.0f / sqrtf(s * (1.f / DM) + NORM_EPS);
#pragma unroll
        for (int j = 0; j < 4; ++j) { const f32x4 gg = ((const GAS f32x4*)F.g_fin)[lane + 64 * j]; q[64 * j] = v[j] * r * gg; }
    }
}

struct Args { const void* in[23]; float* out; unsigned char* ws; int ph_lo, ph_hi; };
static_assert(sizeof(Args) == 23 * 8 + 8 + 8 + 8, "Args has no padding");

__global__ void __launch_bounds__(NWAVES * 64, 2) mk_fwd(Args args) {
    extern __shared__ __attribute__((aligned(16))) unsigned char lds[];
    Frame F;
    F.lds = (LAS unsigned char*)lds;
    F.MISC = (volatile LAS unsigned*)(F.lds + MISC_OFF);
    F.wave = __builtin_amdgcn_readfirstlane((int)threadIdx.x >> 6);
    F.lane = (int)__builtin_amdgcn_mbcnt_hi(~0u, __builtin_amdgcn_mbcnt_lo(~0u, 0u)); F.tid = F.wave * 64 + F.lane;
    F.G = gridDim.x; { const int bx = blockIdx.x; F.vcu = (F.G % 8 == 0) ? (bx % 8) * (F.G / 8) + bx / 8 : bx; }
    F.ws = args.ws; F.ctl = (gu32*)(args.ws + WS_CTL);
    F.x = (const float*)args.in[0]; F.mem = (const float*)args.in[1]; F.pos = (const int*)args.in[2]; F.out = args.out;
    F.g_mix = (const float*)args.in[3]; F.w_in = (const float*)args.in[4]; F.conv_w = (const float*)args.in[5]; F.conv_b = (const float*)args.in[6];
    F.a_w = (const float*)args.in[7]; F.a_b = (const float*)args.in[8]; F.x_w = (const float*)args.in[9]; F.x_b = (const float*)args.in[10]; F.lam = (const float*)args.in[11];
    F.w_out = (const float*)args.in[12]; F.g_cross = (const float*)args.in[13]; F.g_mem = (const float*)args.in[14]; F.w_cq = (const float*)args.in[15]; F.w_ck = (const float*)args.in[16];
    F.w_cv = (const float*)args.in[17]; F.w_co = (const float*)args.in[18]; F.g_mlp = (const float*)args.in[19]; F.w_mi = (const float*)args.in[20]; F.w_mo = (const float*)args.in[21]; F.g_fin = (const float*)args.in[22];
    for (int u = F.tid; u < (LDS_BYTES - LDSCTL_OFF) / 4; u += NWAVES * 64) ((LAS unsigned*)(F.lds + LDSCTL_OFF))[u] = 0u;
    __syncthreads();
    XcdBarrier bar; bar.bar = (unsigned*)(F.ctl + CW_BAR); bar.x = 0; bar.st = nullptr;
    if (N_LAUNCHES == 1) bar = xcd_barrier_post((unsigned*)(F.ctl + CW_BAR), F.MISC + 8, F.tid == 0);
#ifndef PROBE_BARS
#define PROBE_BARS 1
#endif
#define GRID_BAR() do { if (N_LAUNCHES == 1) { for (int nb_ = 0; nb_ < PROBE_BARS; ++nb_) xcd_barrier(bar, F.wave == 0 && F.lane == 0); } } while (0)
    const int lo = args.ph_lo, hi = args.ph_hi;
#ifndef PROBE_DUP
#define PROBE_DUP -1
#endif
#define REP(k) for (int rep_##k = 0; rep_##k < ((k) == PROBE_DUP ? 2 : 1) && ({ asm volatile("" : "+v"(F.lane)); true; }); ++rep_##k)
#define IN(k) (lo <= (k) && (k) < hi)
#define BOTH(k) (IN(k) && IN((k) + 1))
    using namespace pg8;
    bf16_t* XB = wsp<bf16_t>(F, WS_XB); bf16_t* MIXB = wsp<bf16_t>(F, WS_MIX);
    float* SSQ1 = wsp<float>(F, WS_SSQ1); float* SSQ2 = wsp<float>(F, WS_SSQ2);

    if (IN(0)) { REP(0) p0_prologue(F); if (BOTH(0)) GRID_BAR(); }
    if (IN(1)) {
        Gemm g{XB, wsp<bf16_t>(F, WS_WIN), DM, DM, DM, 30, 0};
        OrderP1 S; S.base.init(NT, 2560, F.G, (int)blockIdx.x);
        EpiProj E{wsp<bf16_t>(F, WS_Q), wsp<bf16_t>(F, WS_K), wsp<bf16_t>(F, WS_V), wsp<bf16_t>(F, WS_U), wsp<bf16_t>(F, WS_G), wsp<bf16_t>(F, WS_KVM), wsp<float>(F, WS_RS0), wsp<float>(F, WS_RSM), wsp<float>(F, WS_TAB)};
        REP(1) gemm_phase<EpiProj, OrderP1, true, true>(F.lds + RING_OFF, g, S, E, F.wave);
        if (BOTH(1)) GRID_BAR();
    }
    if (IN(2)) { REP(2) { REP(20) p2_attn_mfma(F); REP(21) p2_cross_weights(F); REP(22) rg_phase<1>(F); } if (BOTH(2)) GRID_BAR(); }
    if (IN(3)) { REP(3) { REP(30) p3_attn_merge(F); REP(31) rg_phase<2>(F); } if (BOTH(3)) GRID_BAR(); }
    if (IN(4)) {
        Gemm g{MIXB, wsp<bf16_t>(F, WS_WOUT), DM, DM, DM, 30, 0};
        StaticOrder S; S.init(NT, DM, F.G, (int)blockIdx.x);
        EpiRes E{F.x, F.out, XB, SSQ1};
        REP(4) gemm_phase<EpiRes, StaticOrder, false, true>(F.lds + RING_OFF, g, S, E, F.wave);
        if (BOTH(4)) GRID_BAR();
    }
    if (IN(5)) {
        Gemm g{XB, wsp<bf16_t>(F, WS_BTS), DM, DM, DM, 4, (size_t)1024 * 1024 * 2};
        StaticOrder S; S.init(NT, DM, F.G, (int)blockIdx.x);
        EpiSoftmax E{SSQ1, MIXB};
        REP(5) gemm_phase<EpiSoftmax, StaticOrder, false, true>(F.lds + RING_OFF, g, S, E, F.wave);
        if (BOTH(5)) GRID_BAR();
    }
    if (IN(6)) {
        Gemm g{MIXB, wsp<bf16_t>(F, WS_BTO), DM, DM, DM, 4, (size_t)1024 * 1024 * 2};
        StaticOrder S; S.init(NT, DM, F.G, (int)blockIdx.x);
        EpiRes E{F.out, F.out, XB, SSQ2};
        if (PROBE_DUP == 6) { EpiRes E0{F.out, wsp<float>(F, WS_HID), wsp<bf16_t>(F, WS_HID + 64 * MiB), SSQ2}; gemm_phase<EpiRes, StaticOrder, false, true>(F.lds + RING_OFF, g, S, E0, F.wave); }
        gemm_phase<EpiRes, StaticOrder, false, true>(F.lds + RING_OFF, g, S, E, F.wave);
        if (BOTH(6)) GRID_BAR();
    }
    if (IN(7)) {
        Gemm g{XB, wsp<bf16_t>(F, WS_WMI), DM, DM, DM, 30, 0};
        StaticOrder S; S.init(NT, FF, F.G, (int)blockIdx.x);
        EpiMlpIn E{SSQ2, wsp<bf16_t>(F, WS_HID)};
        REP(7) gemm_phase<EpiMlpIn, StaticOrder, true, true>(F.lds + RING_OFF, g, S, E, F.wave);
        if (BOTH(7)) GRID_BAR();
    }
    if (IN(8)) {
        Gemm g{wsp<bf16_t>(F, WS_HID), wsp<bf16_t>(F, WS_WMO), FF, FF, FF, 30, 0};
        StaticOrder S; S.init(NT, DM, F.G, (int)blockIdx.x);
        EpiRes E{F.out, F.out, nullptr, nullptr};
        if (PROBE_DUP == 8) { EpiRes E0{F.out, wsp<float>(F, WS_XB), nullptr, nullptr}; gemm_phase<EpiRes, StaticOrder, false, true>(F.lds + RING_OFF, g, S, E0, F.wave); }
        gemm_phase<EpiRes, StaticOrder, false, true>(F.lds + RING_OFF, g, S, E, F.wave);
        if (BOTH(8)) GRID_BAR();
    }
    if (IN(9)) { if (PROBE_DUP == 9) p9_final(F, wsp<float>(F, WS_XB)); p9_final(F, F.out); }
#undef IN
#undef BOTH
}

extern "C" void kernel_launch(void* const* d_in, const int* in_sizes, int n_in, void* d_out, int out_size, void* d_ws, size_t ws_size, hipStream_t stream) {
    static int grid = 0;
    if (grid == 0) {
        if (n_in != 23 || in_sizes[0] != NT * DM || out_size != NT * DM || ws_size < WS_END) { fprintf(stderr, "kernel_launch: unexpected shapes (n_in %d, in0 %d, out %d, ws %zu); nothing launched\n", n_in, n_in > 0 ? in_sizes[0] : -1, out_size, ws_size); grid = -1; return; }
        int dev = 0, cus = 0, per_cu = 0;
        if (hipGetDevice(&dev) != hipSuccess || hipDeviceGetAttribute(&cus, hipDeviceAttributeMultiprocessorCount, dev) != hipSuccess) { grid = -1; return; }
        if (hipFuncSetAttribute((const void*)mk_fwd, hipFuncAttributeMaxDynamicSharedMemorySize, LDS_BYTES) != hipSuccess) { fprintf(stderr, "kernel_launch: hipFuncSetAttribute failed\n"); grid = -1; return; }
        if (hipOccupancyMaxActiveBlocksPerMultiprocessor(&per_cu, (const void*)mk_fwd, NWAVES * 64, LDS_BYTES) != hipSuccess || per_cu < 1) { fprintf(stderr, "kernel_launch: occupancy query says %d workgroups per CU\n", per_cu); }
        (void)hipGetLastError();
        grid = cus;
        if (grid != 256) { fprintf(stderr, "kernel_launch: built for a 256-CU device, found %d CUs; nothing launched\n", grid); grid = -1; return; }
    }
    if (grid < 0) return;
    if (hipMemsetAsync((char*)d_ws + WS_CTL, 0, CTL_ZERO_BYTES, stream) != hipSuccess) { fprintf(stderr, "kernel_launch: hipMemsetAsync failed\n"); return; }
    Args a{};
    for (int i = 0; i < 23; ++i) a.in[i] = d_in[i];
    a.out = (float*)d_out; a.ws = (unsigned char*)d_ws;
    if (N_LAUNCHES == 1) {
        a.ph_lo = 0; a.ph_hi = N_PHASES;
        void* kargs[] = {&a};
        const hipError_t le = hipLaunchCooperativeKernel((const void*)mk_fwd, dim3(grid), dim3(NWAVES * 64), kargs, LDS_BYTES, stream);
        if (le != hipSuccess) fprintf(stderr, "kernel_launch: cooperative launch failed: %s\n", hipGetErrorName(le));
    } else {
        for (int li = 0; li < N_PHASES; ++li) {
            a.ph_lo = li; a.ph_hi = li + 1;
            hipLaunchKernelGGL(mk_fwd, dim3(grid), dim3(NWAVES * 64), LDS_BYTES, stream, a);
        }
    }
}
```
